# Optimizing an MI355X kernel written in HIP

```python
import math
import jax, jax.numpy as jnp
from jax import lax
import numpy as np

D_MODEL = 1024
BATCH = 16
SEQ = 256
DEPTH = 4
DEC_BATCH = 2
DEC_SEQ = 4096
PAST_LEN = 512

GRID_W = 64
N_MIXERS = 4
N_A = (DEPTH + 3) // N_MIXERS
N_B = (DEPTH + 2) // N_MIXERS
N_C = (DEPTH + 1) // N_MIXERS
N_D = DEPTH // N_MIXERS
D_FF = 2816
MACARON_W = 0.5
RMS_EPS = 1e-6
NEG_INF = -1e30
Q_BLOCK = 128
A_HEADS = 16
A_KV_HEADS = 4
A_HEAD_DIM = D_MODEL // A_HEADS
A_WINDOW = 128
A_BLOCK = 128
ROPE_BASE = 10000.0
S5_GROUP = 16
S5_GROUPS = D_MODEL // S5_GROUP
S5_STATE = 64
C_HEADS = 16
C_HEAD_DIM = D_MODEL // C_HEADS
NA_ROWS = 8
NA_COLS = 16
DN_QK_HEADS = 4
DN_V_HEADS = 8
DN_HEAD_DIM = 128
DN_CONV = 5
DN_CHUNK = 64

kernel_name = 'hybrid_diffusion_prefix_trunk_step'

F32 = jnp.float32


def rmsnorm(x, g):
    xf = x.astype(F32)
    y = xf * lax.rsqrt(jnp.mean(xf * xf, axis=-1, keepdims=True) + RMS_EPS)
    return (y * g.astype(F32)).astype(x.dtype)


def l2norm(x):
    xf = x.astype(F32)
    return (xf * lax.rsqrt(jnp.sum(xf * xf, axis=-1, keepdims=True) + RMS_EPS)).astype(x.dtype)


def swiglu(h, w_gu, w_d):
    g, u = jnp.split(h @ w_gu, 2, axis=-1)
    return (jax.nn.silu(g) * u) @ w_d


def rotate(x, ang):
    ang = ang.reshape((ang.shape[0],) + (1,) * (x.ndim - 3) + (ang.shape[1],))
    cos, sin = jnp.cos(ang).astype(x.dtype), jnp.sin(ang).astype(x.dtype)
    x1, x2 = jnp.split(x, 2, axis=-1)
    return jnp.concatenate([x1 * cos - x2 * sin, x2 * cos + x1 * sin], axis=-1)


def axial_rope(x):
    L, d = x.shape[1], x.shape[-1]
    n = d // 4
    inv = ROPE_BASE ** (-jnp.arange(n, dtype=F32) / n)
    t = jnp.arange(L)
    ang_r = (t // GRID_W).astype(F32)[:, None] * inv[None, :]
    ang_c = (t % GRID_W).astype(F32)[:, None] * inv[None, :]
    half = d // 2
    return jnp.concatenate([rotate(x[..., :half], ang_r), rotate(x[..., half:], ang_c)], axis=-1)


def blocked_attention(q, k, v, sink):
    B, Lq = q.shape[:2]
    nb = Lq // Q_BLOCK
    scale = q.shape[-1] ** -0.5
    qb = jnp.moveaxis(q.reshape((B, nb, Q_BLOCK) + q.shape[2:]), 1, 0)

    def one_block(qblk):
        s = jnp.einsum('bikgd,bjkd->bkgij', qblk, k).astype(F32) * scale
        if sink is not None:
            sk = jnp.broadcast_to(sink.astype(F32)[None, :, :, None, None], s.shape[:-1] + (1,))
            p = jax.nn.softmax(jnp.concatenate([s, sk], axis=-1), axis=-1)[..., :-1]
        else:
            p = jax.nn.softmax(s, axis=-1)
        return jnp.einsum('bkgij,bjkd->bikgd', p.astype(v.dtype), v)

    o = lax.map(one_block, qb)
    return jnp.moveaxis(o, 0, 1).reshape(q.shape)


def gqa_project(h, w_qkv):
    B, L, _ = h.shape
    G = A_HEADS // A_KV_HEADS
    q, k, v = jnp.split(h @ w_qkv, [A_HEADS * A_HEAD_DIM, (A_HEADS + A_KV_HEADS) * A_HEAD_DIM], axis=-1)
    return (q.reshape(B, L, A_KV_HEADS, G, A_HEAD_DIM), k.reshape(B, L, A_KV_HEADS, A_HEAD_DIM),
            v.reshape(B, L, A_KV_HEADS, A_HEAD_DIM))


def mixer_a_ctx(h, w_qkv, w_o, sink):
    B, L, _ = h.shape
    q, k, v = gqa_project(h, w_qkv)
    o = blocked_attention(q, k, v, sink.reshape(A_KV_HEADS, A_HEADS // A_KV_HEADS))
    return o.reshape(B, L, -1) @ w_o, (k, v)


def mixer_a_lat(h, w_qkv, w_o, sink, k_ctx, v_ctx):
    B, L, _ = h.shape
    G = A_HEADS // A_KV_HEADS
    q, k, v = gqa_project(h, w_qkv)
    q, k = axial_rope(q), axial_rope(k)
    nb = L // A_BLOCK
    side = A_WINDOW // A_BLOCK
    width = (2 * side + 1) * A_BLOCK

    def band(t):
        tp = jnp.pad(t, ((0, 0), (side * A_BLOCK, side * A_BLOCK), (0, 0), (0, 0)))
        tp = tp.reshape((B, nb + 2 * side, A_BLOCK) + t.shape[2:])
        return jnp.concatenate([tp[:, o:o + nb] for o in range(2 * side + 1)], axis=2)

    kb, vb = band(k), band(v)
    qb = q.reshape(B, nb, A_BLOCK, A_KV_HEADS, G, A_HEAD_DIM)
    blk = jnp.arange(nb)[:, None] * A_BLOCK
    q_pos = blk + jnp.arange(A_BLOCK)[None, :]
    k_pos = blk - side * A_BLOCK + jnp.arange(width)[None, :]
    ok = ((jnp.abs(k_pos[:, None, :] - q_pos[:, :, None]) <= A_WINDOW)
          & ((k_pos >= 0) & (k_pos < L))[:, None, :])
    scale = A_HEAD_DIM ** -0.5
    s_loc = jnp.einsum('bnikgd,bnjkd->bnkgij', qb, kb).astype(F32) * scale
    s_loc = jnp.where(ok[None, :, None, None], s_loc, NEG_INF)
    s_ctx = jnp.einsum('bnikgd,bmkd->bnkgim', qb, k_ctx).astype(F32) * scale
    sk = jnp.broadcast_to(sink.astype(F32).reshape(1, 1, A_KV_HEADS, G, 1, 1), s_loc.shape[:-1] + (1,))
    p = jax.nn.softmax(jnp.concatenate([s_loc, s_ctx, sk], axis=-1), axis=-1).astype(v.dtype)
    o = (jnp.einsum('bnkgij,bnjkd->bnikgd', p[..., :width], vb)
         + jnp.einsum('bnkgim,bmkd->bnikgd', p[..., width:-1], v_ctx))
    return o.reshape(B, L, -1) @ w_o, None


def complex_affine_combine(e1, e2):
    a1r, a1i, b1r, b1i = e1
    a2r, a2i, b2r, b2i = e2
    return (a2r * a1r - a2i * a1i, a2r * a1i + a2i * a1r,
            a2r * b1r - a2i * b1i + b2r, a2r * b1i + a2i * b1r + b2i)


def s5_scan(u, lam_re, lam_im, log_dt, b_re, b_im, h0):
    lam_re, lam_im = lam_re.astype(F32), lam_im.astype(F32)
    dt = jnp.exp(log_dt.astype(F32))[:, None]
    lr, li = lam_re * dt, lam_im * dt
    a_re, a_im = jnp.exp(lr) * jnp.cos(li), jnp.exp(lr) * jnp.sin(li)
    den = lam_re * lam_re + lam_im * lam_im
    fr = ((a_re - 1.0) * lam_re + a_im * lam_im) / den
    fi = (a_im * lam_re - (a_re - 1.0) * lam_im) / den
    b_re, b_im = b_re.astype(F32), b_im.astype(F32)
    bb_re = fr[..., None] * b_re - fi[..., None] * b_im
    bb_im = fr[..., None] * b_im + fi[..., None] * b_re
    bu_re = jnp.einsum('blgc,gpc->blgp', u, bb_re)
    bu_im = jnp.einsum('blgc,gpc->blgp', u, bb_im)
    if h0 is not None:
        bu_re = jnp.concatenate([h0[0][:, None], bu_re], axis=1)
        bu_im = jnp.concatenate([h0[1][:, None], bu_im], axis=1)
    A_re, A_im = jnp.broadcast_to(a_re, bu_re.shape), jnp.broadcast_to(a_im, bu_re.shape)
    _, _, xr, xi = lax.associative_scan(complex_affine_combine, (A_re, A_im, bu_re, bu_im), axis=1)
    if h0 is not None:
        xr, xi = xr[:, 1:], xi[:, 1:]
    return xr, xi


def mixer_s5(h, p, state_re=None, state_im=None):
    lam_re, lam_im, log_dt, b_re, b_im, c_re, c_im, d_skip, w_glu = p
    B, L, _ = h.shape
    u = h.astype(F32).reshape(B, L, S5_GROUPS, S5_GROUP)
    y = jnp.zeros_like(u)
    fin_re, fin_im = [], []
    for d in range(2):
        ud = u if d == 0 else jnp.flip(u, 1)
        h0 = None if state_re is None else (state_re[:, d].astype(F32), state_im[:, d].astype(F32))
        xr, xi = s5_scan(ud, lam_re[d], lam_im[d], log_dt[d], b_re[d], b_im[d], h0)
        yd = (jnp.einsum('gcp,blgp->blgc', c_re[d].astype(F32), xr)
              - jnp.einsum('gcp,blgp->blgc', c_im[d].astype(F32), xi))
        y = y + (yd if d == 0 else jnp.flip(yd, 1))
        if state_re is None:
            fin_re.append(xr[:, -1])
            fin_im.append(xi[:, -1])
    y = y.reshape(B, L, D_MODEL).astype(h.dtype) + d_skip * h
    a, gt = jnp.split(jax.nn.gelu(y) @ w_glu, 2, axis=-1)
    out = a * jax.nn.sigmoid(gt)
    aux = (jnp.stack(fin_re, 1), jnp.stack(fin_im, 1)) if state_re is None else None
    return out, aux


def na_project(h, w_qkv):
    B, L, _ = h.shape
    return [t.reshape(B, L, C_HEADS, C_HEAD_DIM) for t in jnp.split(h @ w_qkv, 3, axis=-1)]


def mixer_na_ctx(h, w_qkv, w_o):
    B, L, _ = h.shape
    q, k, v = na_project(h, w_qkv)
    o = blocked_attention(q[:, :, :, None], k, v, None)
    return o.reshape(B, L, -1) @ w_o, (k, v)


def mixer_na_lat(h, w_qkv, w_o, rpb, k_ctx, v_ctx):
    B, L, _ = h.shape
    rows = L // GRID_W
    kh = min(NA_ROWS, rows)
    q, k, v = [t.reshape(B, rows, GRID_W, C_HEADS, C_HEAD_DIM) for t in na_project(h, w_qkv)]
    r = jnp.arange(rows)
    row_idx = jnp.clip(r - kh // 2, 0, rows - kh)[:, None] + jnp.arange(kh)[None, :]
    kr, vr = k[:, row_idx], v[:, row_idx]
    col = jnp.arange(GRID_W)
    col_start = jnp.clip(col - NA_COLS // 2, 0, GRID_W - NA_COLS)
    col_ok = (col[None, :] >= col_start[:, None]) & (col[None, :] < col_start[:, None] + NA_COLS)
    d_row = row_idx - r[:, None]
    d_col = jnp.clip(col[None, :] - col[:, None], 1 - NA_COLS, NA_COLS - 1)
    bias = rpb[:, (d_row + NA_ROWS - 1)[:, None, :, None], (d_col + NA_COLS - 1)[None, :, None, :]]
    scale = C_HEAD_DIM ** -0.5
    s = jnp.einsum('brqhd,brjkhd->bhrqjk', q, kr).astype(F32) * scale + bias[None].astype(F32)
    s = jnp.where(col_ok[:, None, :], s, NEG_INF).reshape(B, C_HEADS, rows, GRID_W, kh * GRID_W)
    s_ctx = jnp.einsum('brqhd,bmhd->bhrqm', q, k_ctx).astype(F32) * scale
    p = jax.nn.softmax(jnp.concatenate([s, s_ctx], axis=-1), axis=-1).astype(v.dtype)
    n_loc = kh * GRID_W
    p_loc = p[..., :n_loc].reshape(B, C_HEADS, rows, GRID_W, kh, GRID_W)
    o = (jnp.einsum('bhrqjk,brjkhd->brqhd', p_loc, vr)
         + jnp.einsum('bhrqm,bmhd->brqhd', p[..., n_loc:], v_ctx))
    return o.reshape(B, L, -1) @ w_o, None


def centred_conv(x, w):
    K, C = w.shape
    return lax.conv_general_dilated(x, w[:, None, :], window_strides=(1,), padding=[(K // 2, K // 2)],
                                    dimension_numbers=('NWC', 'WIO', 'NWC'), feature_group_count=C)


def gated_delta_rule(q, k, v, g, beta, s0):
    B, L, H, dk = k.shape
    dv = v.shape[-1]
    n = L // DN_CHUNK

    def chunk(t):
        t = t.astype(F32).reshape((B, n, DN_CHUNK) + t.shape[2:])
        return jnp.swapaxes(t, 2, 3)

    q, k, v, g, beta = [chunk(t) for t in (q, k, v, g, beta)]
    gc = jnp.cumsum(g, axis=-1)
    idx = jnp.arange(DN_CHUNK)
    lower = idx[:, None] >= idx[None, :]
    strict = idx[:, None] > idx[None, :]
    decay = jnp.exp(jnp.where(lower, gc[..., :, None] - gc[..., None, :], NEG_INF))
    kb = k * beta[..., None]
    lmat = jnp.where(strict, jnp.einsum('bnhid,bnhjd->bnhij', kb, k) * decay, 0.0)
    rhs = jnp.concatenate([v * beta[..., None], kb * jnp.exp(gc)[..., None]], axis=-1)
    sol = lax.linalg.triangular_solve(lmat + jnp.eye(DN_CHUNK, dtype=F32), rhs, left_side=True, lower=True)
    u, w = sol[..., :dv], sol[..., dv:]
    a_qk = jnp.where(lower, jnp.einsum('bnhid,bnhjd->bnhij', q, k) * decay, 0.0)

    def step(S, xs):
        q_c, k_c, u_c, w_c, g_c, a_c = xs
        v_new = u_c - jnp.einsum('bhcd,bhde->bhce', w_c, S)
        o = (jnp.einsum('bhcd,bhde->bhce', q_c * jnp.exp(g_c)[..., None], S)
             + jnp.einsum('bhij,bhje->bhie', a_c, v_new))
        g_last = g_c[..., -1:]
        S = (S * jnp.exp(g_last)[..., None]
             + jnp.einsum('bhcd,bhce->bhde', k_c * jnp.exp(g_last - g_c)[..., None], v_new))
        return S, o

    xs = tuple(jnp.moveaxis(t, 1, 0) for t in (q, k, u, w, gc, a_qk))
    S, o = lax.scan(step, s0.astype(F32), xs)
    o = jnp.swapaxes(jnp.moveaxis(o, 0, 1), 2, 3).reshape(B, L, H, dv)
    return o, S


def mixer_dn(h, p, state=None):
    w_in, conv_w, w_ba, a_log, dt_bias, out_g, w_o = p
    B, L, _ = h.shape
    nqk = DN_QK_HEADS * DN_HEAD_DIM
    nv = DN_V_HEADS * DN_HEAD_DIM
    proj = h @ w_in
    qkv = jax.nn.silu(centred_conv(proj[..., :2 * nqk + nv], conv_w))
    z = proj[..., 2 * nqk + nv:].reshape(B, L, DN_V_HEADS, DN_HEAD_DIM)
    rep = DN_V_HEADS // DN_QK_HEADS
    q = jnp.repeat(l2norm(qkv[..., :nqk].reshape(B, L, DN_QK_HEADS, DN_HEAD_DIM)), rep, axis=2) * DN_HEAD_DIM ** -0.5
    k = jnp.repeat(l2norm(qkv[..., nqk:2 * nqk].reshape(B, L, DN_QK_HEADS, DN_HEAD_DIM)), rep, axis=2)
    v = qkv[..., 2 * nqk:].reshape(B, L, DN_V_HEADS, DN_HEAD_DIM)
    o_sum = jnp.zeros((B, L, DN_V_HEADS, DN_HEAD_DIM), F32)
    finals = []
    for d in range(2):
        b_raw, a_raw = jnp.split((h @ w_ba[d]).astype(F32), 2, axis=-1)
        beta = jax.nn.sigmoid(b_raw)
        g = -jnp.exp(a_log[d].astype(F32)) * jax.nn.softplus(a_raw + dt_bias[d].astype(F32))
        seqs = (q, k, v, g, beta) if d == 0 else tuple(jnp.flip(t, 1) for t in (q, k, v, g, beta))
        s0 = jnp.zeros((B, DN_V_HEADS, DN_HEAD_DIM, DN_HEAD_DIM), F32) if state is None else state[:, d]
        o, S = gated_delta_rule(*seqs, s0)
        o_sum = o_sum + (o if d == 0 else jnp.flip(o, 1))
        if state is None:
            finals.append(S)
    o = rmsnorm(o_sum, out_g) * jax.nn.silu(z.astype(F32))
    out = o.astype(h.dtype).reshape(B, L, -1) @ w_o
    return out, (jnp.stack(finals, 1) if state is None else None)


def trunk_layer(x, cond, i, mix, norm_g, w_ada, b_ada, ffn_w_gu, ffn_w_d):
    mods = jnp.split((jax.nn.silu(cond) @ w_ada[i] + b_ada[i])[:, None, :], 9, axis=-1)

    def sub(x, s, f, weight):
        shift, scale, gate = mods[3 * s], mods[3 * s + 1], mods[3 * s + 2]
        y, aux = f(rmsnorm(x, norm_g[i, 2 * s]) * (1.0 + scale) + shift)
        return x + weight * gate * rmsnorm(y, norm_g[i, 2 * s + 1]), aux

    x, _ = sub(x, 0, lambda t: (swiglu(t, ffn_w_gu[i, 0], ffn_w_d[i, 0]), None), MACARON_W)
    x, aux = sub(x, 1, mix, 1.0)
    x, _ = sub(x, 2, lambda t: (swiglu(t, ffn_w_gu[i, 1], ffn_w_d[i, 1]), None), MACARON_W)
    return x, aux


def setup_inputs(seed: int = 0) -> dict:
    key = jax.random.key(seed)
    ks = iter(jax.random.split(key, 64))

    def nrm(shape, scale=1.0):
        return scale * jax.random.normal(next(ks), shape, F32)

    def unif(shape, lo, hi):
        return jax.random.uniform(next(ks), shape, F32, lo, hi)

    D = D_MODEL
    nqkv = 2 * DN_QK_HEADS * DN_HEAD_DIM + DN_V_HEADS * DN_HEAD_DIM
    s5_shape = (N_B, 2, S5_GROUPS, S5_STATE)
    dn_dt = jnp.exp(unif((N_D, 2, DN_V_HEADS), math.log(1e-3), math.log(1e-1)))
    return {
        'x_prompt': nrm((BATCH, SEQ, D)),
        'x_sample': nrm((DEC_BATCH, DEC_SEQ, D)),
        'cache_attn_k': nrm((DEC_BATCH, N_A, PAST_LEN, A_KV_HEADS, A_HEAD_DIM)),
        'cache_attn_v': nrm((DEC_BATCH, N_A, PAST_LEN, A_KV_HEADS, A_HEAD_DIM)),
        'state_s5_re': nrm((DEC_BATCH, N_B, 2, S5_GROUPS, S5_STATE), 0.1),
        'state_s5_im': nrm((DEC_BATCH, N_B, 2, S5_GROUPS, S5_STATE), 0.1),
        'cache_na_k': nrm((DEC_BATCH, N_C, PAST_LEN, C_HEADS, C_HEAD_DIM)),
        'cache_na_v': nrm((DEC_BATCH, N_C, PAST_LEN, C_HEADS, C_HEAD_DIM)),
        'state_dn': nrm((DEC_BATCH, N_D, 2, DN_V_HEADS, DN_HEAD_DIM, DN_HEAD_DIM), 0.1),
        'c': nrm((DEC_BATCH, D)),
        'c_ctx': nrm((D,)),
        'norm_g': 1.0 + nrm((DEPTH, 6, D), 0.02),
        'w_ada': nrm((DEPTH, D, 9 * D), 0.5 * D ** -0.5),
        'b_ada': nrm((DEPTH, 9 * D), 0.01),
        'ffn_w_gu': nrm((DEPTH, 2, D, 2 * D_FF), D ** -0.5),
        'ffn_w_d': nrm((DEPTH, 2, D_FF, D), D_FF ** -0.5),
        'a_w_qkv': nrm((N_A, D, (A_HEADS + 2 * A_KV_HEADS) * A_HEAD_DIM), D ** -0.5),
        'a_w_o': nrm((N_A, A_HEADS * A_HEAD_DIM, D), (A_HEADS * A_HEAD_DIM) ** -0.5),
        'a_sink': nrm((N_A, A_HEADS)),
        's5_lam_re': -0.5 + nrm(s5_shape, 0.01),
        's5_lam_im': math.pi * jnp.arange(S5_STATE, dtype=F32) + nrm(s5_shape, 0.01),
        's5_log_dt': unif((N_B, 2, S5_GROUPS), math.log(1e-3), math.log(1e-1)),
        's5_b_re': nrm((N_B, 2, S5_GROUPS, S5_STATE, S5_GROUP), (2 * S5_GROUP) ** -0.5),
        's5_b_im': nrm((N_B, 2, S5_GROUPS, S5_STATE, S5_GROUP), (2 * S5_GROUP) ** -0.5),
        's5_c_re': nrm((N_B, 2, S5_GROUPS, S5_GROUP, S5_STATE), 0.5),
        's5_c_im': nrm((N_B, 2, S5_GROUPS, S5_GROUP, S5_STATE), 0.5),
        's5_d': nrm((N_B, D), 0.5),
        's5_w_glu': nrm((N_B, D, 2 * D), D ** -0.5),
        'na_w_qkv': nrm((N_C, D, 3 * C_HEADS * C_HEAD_DIM), D ** -0.5),
        'na_w_o': nrm((N_C, C_HEADS * C_HEAD_DIM, D), (C_HEADS * C_HEAD_DIM) ** -0.5),
        'na_rpb': nrm((N_C, C_HEADS, 2 * NA_ROWS - 1, 2 * NA_COLS - 1), 0.1),
        'dn_w_in': nrm((N_D, D, nqkv + DN_V_HEADS * DN_HEAD_DIM), D ** -0.5),
        'dn_conv_w': nrm((N_D, DN_CONV, nqkv), DN_CONV ** -0.5),
        'dn_w_ba': nrm((N_D, 2, D, 2 * DN_V_HEADS), D ** -0.5),
        'dn_a_log': jnp.log(unif((N_D, 2, DN_V_HEADS), 1.0, 16.0)),
        'dn_dt_bias': dn_dt + jnp.log(-jnp.expm1(-dn_dt)),
        'dn_out_g': 1.0 + nrm((N_D, DN_HEAD_DIM), 0.02),
        'dn_w_o': nrm((N_D, DN_V_HEADS * DN_HEAD_DIM, D), (DN_V_HEADS * DN_HEAD_DIM) ** -0.5),
    }


def reference(x_prompt, x_sample, cache_attn_k, cache_attn_v, state_s5_re, state_s5_im, cache_na_k, cache_na_v,
              state_dn, c, c_ctx, norm_g, w_ada, b_ada, ffn_w_gu, ffn_w_d, a_w_qkv, a_w_o, a_sink,
              s5_lam_re, s5_lam_im, s5_log_dt, s5_b_re, s5_b_im, s5_c_re, s5_c_im, s5_d, s5_w_glu,
              na_w_qkv, na_w_o, na_rpb, dn_w_in, dn_conv_w, dn_w_ba, dn_a_log, dn_dt_bias, dn_out_g, dn_w_o):
    common = (norm_g, w_ada, b_ada, ffn_w_gu, ffn_w_d)

    def s5_params(j):
        return (s5_lam_re[j], s5_lam_im[j], s5_log_dt[j], s5_b_re[j], s5_b_im[j], s5_c_re[j], s5_c_im[j],
                s5_d[j], s5_w_glu[j])

    def dn_params(j):
        return (dn_w_in[j], dn_conv_w[j], dn_w_ba[j], dn_a_log[j], dn_dt_bias[j], dn_out_g[j], dn_w_o[j])

    y = x_prompt
    cond_ctx = c_ctx[None, :]
    ctx_state = ([], [], [], [])
    for i in range(DEPTH):
        kind, j = i % N_MIXERS, i // N_MIXERS
        if kind == 0:
            mix = lambda t: mixer_a_ctx(t, a_w_qkv[j], a_w_o[j], a_sink[j])
        elif kind == 1:
            mix = lambda t: mixer_s5(t, s5_params(j))
        elif kind == 2:
            mix = lambda t: mixer_na_ctx(t, na_w_qkv[j], na_w_o[j])
        else:
            mix = lambda t: mixer_dn(t, dn_params(j))
        y, aux = trunk_layer(y, cond_ctx, i, mix, *common)
        ctx_state[kind].append(aux)
    new_attn_k = jnp.stack([s[0] for s in ctx_state[0]], 1)
    new_attn_v = jnp.stack([s[1] for s in ctx_state[0]], 1)
    new_s5_re = jnp.stack([s[0] for s in ctx_state[1]], 1)
    new_s5_im = jnp.stack([s[1] for s in ctx_state[1]], 1)
    new_na_k = jnp.stack([s[0] for s in ctx_state[2]], 1)
    new_na_v = jnp.stack([s[1] for s in ctx_state[2]], 1)
    new_dn = jnp.stack(ctx_state[3], 1)

    z = x_sample
    for i in range(DEPTH):
        kind, j = i % N_MIXERS, i // N_MIXERS
        if kind == 0:
            mix = lambda t: mixer_a_lat(t, a_w_qkv[j], a_w_o[j], a_sink[j], cache_attn_k[:, j], cache_attn_v[:, j])
        elif kind == 1:
            mix = lambda t: mixer_s5(t, s5_params(j), state_s5_re[:, j], state_s5_im[:, j])
        elif kind == 2:
            mix = lambda t: mixer_na_lat(t, na_w_qkv[j], na_w_o[j], na_rpb[j], cache_na_k[:, j], cache_na_v[:, j])
        else:
            mix = lambda t: mixer_dn(t, dn_params(j), state_dn[:, j])
        z, _ = trunk_layer(z, c, i, mix, *common)

    return (y, z, new_attn_k, new_attn_v, new_s5_re, new_s5_im, new_na_k, new_na_v, new_dn)
```

```cpp
#include <hip/hip_runtime.h>
#include <hip/hip_cooperative_groups.h>
#include <cstdio>
namespace cg = cooperative_groups;

#ifndef MULTI_LAUNCH
#define MULTI_LAUNCH 0
#endif

typedef unsigned short u16;
using bf16x8 = __attribute__((ext_vector_type(8))) short;
using f32x4 = __attribute__((ext_vector_type(4))) float;
#define DEVI __device__ __forceinline__

constexpr int T = 12288, TC = 4096, D = 1024, DFF = 2816;
constexpr int SMEM = 128 * 1024;
constexpr int NPH = 46;

constexpr size_t OFF_WT_GU = 0;
constexpr size_t OFF_WT_D = OFF_WT_GU + (size_t)8 * 5632 * 1024 * 2;
constexpr size_t OFF_WT_AQKV = OFF_WT_D + (size_t)8 * 1024 * 2816 * 2;
constexpr size_t OFF_WT_AO = OFF_WT_AQKV + (size_t)1536 * 1024 * 2;
constexpr size_t OFF_WT_GLU = OFF_WT_AO + (size_t)1024 * 1024 * 2;
constexpr size_t OFF_WT_NQKV = OFF_WT_GLU + (size_t)2048 * 1024 * 2;
constexpr size_t OFF_WT_NO = OFF_WT_NQKV + (size_t)3072 * 1024 * 2;
constexpr size_t OFF_WT_DIN = OFF_WT_NO + (size_t)1024 * 1024 * 2;
constexpr size_t OFF_WT_DO = OFF_WT_DIN + (size_t)3328 * 1024 * 2;
constexpr size_t OFF_MODS = OFF_WT_DO + (size_t)1024 * 1024 * 2;
constexpr size_t OFF_H = OFF_MODS + (size_t)4 * 3 * 9216 * 4;
constexpr size_t OFF_ACT = OFF_H + (size_t)T * 1024 * 2;
constexpr size_t OFF_Y = OFF_ACT + (size_t)T * 2816 * 2;
constexpr size_t OFF_MIX = OFF_Y + (size_t)T * 1024 * 4;
constexpr size_t MX_HF = 0;
constexpr size_t MX_YD = MX_HF + (size_t)T * 1024 * 4;
constexpr size_t MX_E = MX_YD + (size_t)2 * T * 1024 * 4;
constexpr size_t MX_RAW = 0;
constexpr size_t MX_ZB = MX_RAW + (size_t)T * 2048 * 4;
constexpr size_t MX_QC = MX_ZB + (size_t)T * 1280 * 4;
constexpr size_t MX_KC = MX_QC + (size_t)T * 512 * 4;
constexpr size_t MX_VC = MX_KC + (size_t)T * 512 * 4;
constexpr size_t MX_W = MX_VC + (size_t)T * 1024 * 4;
constexpr size_t MX_BETA = MX_W + (size_t)3072 * 64 * 128 * 4;
constexpr size_t MX_G = MX_BETA + (size_t)2 * T * 8 * 4;
constexpr size_t MX_O1 = MX_G + (size_t)2 * T * 8 * 4;
constexpr size_t MX_END = MX_O1 + (size_t)T * 1024 * 4;
constexpr size_t AX_AQK = 0;
constexpr size_t AX_GC = AX_AQK + (size_t)3072 * 64 * 64 * 4;
constexpr size_t OFF_BAR = OFF_MIX + MX_END;
constexpr size_t WS_NEED = OFF_BAR + 16384;

constexpr size_t OUT_AK = (size_t)T * 1024;
constexpr size_t OUT_AV = OUT_AK + 1048576;
constexpr size_t OUT_SRE = OUT_AV + 1048576;
constexpr size_t OUT_SIM = OUT_SRE + 131072;
constexpr size_t OUT_NK = OUT_SIM + 131072;
constexpr size_t OUT_NV = OUT_NK + 4194304;
constexpr size_t OUT_DN = OUT_NV + 4194304;

struct P {
  const float *x_prompt, *x_sample, *cache_ak, *cache_av, *s5_sre, *s5_sim, *cache_nk, *cache_nv, *state_dn, *c, *c_ctx;
  const float *norm_g, *w_ada, *b_ada, *w_gu, *w_d, *a_wqkv, *a_wo, *a_sink;
  const float *lam_re, *lam_im, *log_dt, *b_re, *b_im, *c_re, *c_im, *s5_d, *s5_wglu;
  const float *na_wqkv, *na_wo, *na_rpb, *dn_win, *dn_conv, *dn_wba, *dn_alog, *dn_dtb, *dn_outg, *dn_wo;
  float* out;
  char* ws;
  int lo, hi;
};

typedef __attribute__((ext_vector_type(2))) __bf16 bf16x2_t;
typedef __attribute__((ext_vector_type(2))) float f32x2_t;
DEVI unsigned pk2bf(float lo, float hi) {
  bf16x2_t r = __builtin_convertvector((f32x2_t){lo, hi}, bf16x2_t);
  return __builtin_bit_cast(unsigned, r);
}
DEVI u16 f2bf(float f) { return (u16)pk2bf(f, f); }
template <typename Tp>
DEVI Tp* uni(Tp* ptr) {
  unsigned long long v = (unsigned long long)ptr;
  unsigned lo = __builtin_amdgcn_readfirstlane((unsigned)v), hi = __builtin_amdgcn_readfirstlane((unsigned)(v >> 32));
  return (Tp*)(((unsigned long long)hi << 32) | lo);
}
DEVI float dpp_ror(float v, const int ctrl) { return v; }
#define ROW_ROR(v, n) __builtin_bit_cast(float, __builtin_amdgcn_update_dpp(0, __builtin_bit_cast(int, (v)), 0x120 + (n), 0xf, 0xf, false))
DEVI float rowmax16(float v) {
  v = fmaxf(v, ROW_ROR(v, 8)); v = fmaxf(v, ROW_ROR(v, 4)); v = fmaxf(v, ROW_ROR(v, 2)); v = fmaxf(v, ROW_ROR(v, 1));
  return v;
}
DEVI float rowsum16(float v) {
  v += ROW_ROR(v, 8); v += ROW_ROR(v, 4); v += ROW_ROR(v, 2); v += ROW_ROR(v, 1);
  return v;
}
typedef __attribute__((ext_vector_type(4))) float nt_f4;
DEVI float4 ld_nt(const float4* p) { nt_f4 v = __builtin_nontemporal_load((const nt_f4*)p); return make_float4(v.x, v.y, v.z, v.w); }
DEVI float wsum(float v) {
  v = rowsum16(v);
  v += __shfl_xor(v, 16); v += __shfl_xor(v, 32);
  return v;
}
DEVI float sigmoidf_(float v) { return 1.f / (1.f + expf(-v)); }
DEVI bf16x8 pack8(const float* v) {
  typedef __attribute__((ext_vector_type(4))) unsigned u32x4_t;
  u32x4_t r = {pk2bf(v[0], v[1]), pk2bf(v[2], v[3]), pk2bf(v[4], v[5]), pk2bf(v[6], v[7])};
  return __builtin_bit_cast(bf16x8, r);
}

DEVI void tjob(const P& p, int t, const float*& src, u16*& dst, int& K, int& N, int& F, int& id) {
  if (t < 11264) { int m = t / 1408; id = t % 1408; src = p.w_gu + (size_t)m * 1024 * 5632; dst = (u16*)(p.ws + OFF_WT_GU) + (size_t)m * 5632 * 1024; K = 1024; N = 5632; F = 2816; return; }
  t -= 11264;
  if (t < 5632) { int m = t / 704; id = t % 704; src = p.w_d + (size_t)m * 2816 * 1024; dst = (u16*)(p.ws + OFF_WT_D) + (size_t)m * 1024 * 2816; K = 2816; N = 1024; F = 0; return; }
  t -= 5632;
  K = 1024; F = 0;
  if (t < 384) { id = t; src = p.a_wqkv; dst = (u16*)(p.ws + OFF_WT_AQKV); N = 1536; return; }
  t -= 384;
  if (t < 256) { id = t; src = p.a_wo; dst = (u16*)(p.ws + OFF_WT_AO); N = 1024; return; }
  t -= 256;
  if (t < 512) { id = t; src = p.s5_wglu; dst = (u16*)(p.ws + OFF_WT_GLU); N = 2048; F = 1024; return; }
  t -= 512;
  if (t < 768) { id = t; src = p.na_wqkv; dst = (u16*)(p.ws + OFF_WT_NQKV); N = 3072; return; }
  t -= 768;
  if (t < 256) { id = t; src = p.na_wo; dst = (u16*)(p.ws + OFF_WT_NO); N = 1024; return; }
  t -= 256;
  if (t < 768) { id = t; src = p.dn_win; dst = (u16*)(p.ws + OFF_WT_DIN); N = 3072; return; }
  t -= 768;
  id = t; src = p.dn_wo; dst = (u16*)(p.ws + OFF_WT_DO); N = 1024;
}
constexpr int NTJ = 11264 + 5632 + 384 + 256 + 512 + 768 + 256 + 768 + 256;

DEVI void prep_phase(const P& p, int bid, int nb, char* smem, const int tidx) {
  const int tid = tidx;
  {
    const float4* s0 = (const float4*)p.x_prompt;
    const float4* s1 = (const float4*)p.x_sample;
    float4* dst = (float4*)p.out;
    const int n0 = TC * D / 4, n = T * D / 4;
    for (int i = bid * 256 + tid; i < n; i += nb * 256) dst[i] = i < n0 ? s0[i] : s1[i - n0];
  }
  {
    u16* dst = (u16*)(p.ws + OFF_WT_DIN) + (size_t)3072 * 1024;
    for (int i = bid * 256 + tid; i < 256 * 1024; i += nb * 256) {
      int r = i >> 10, k = i & 1023;
      float v = r < 32 ? p.dn_wba[((size_t)(r >> 4) * 1024 + k) * 16 + (r & 15)] : 0.f;
      dst[i] = f2bf(v);
    }
  }
  {
    float* sc = (float*)smem;
    float* red = sc + 3072;
    bool staged = false;
    float* mods = (float*)(p.ws + OFF_MODS);
    for (int it = bid; it < 576; it += nb) {
      if (!staged) {
        for (int k = tid; k < 3072; k += 256) { float v = k < 1024 ? p.c_ctx[k] : p.c[k - 1024]; sc[k] = v / (1.f + expf(-v)); }
        __syncthreads();
        staged = true;
      }
      int i = it / 144, cgp = it % 144;
      int cl = tid & 63, kq = tid >> 6;
      int col = cgp * 64 + cl;
      const float* w = p.w_ada + ((size_t)i * 1024 + kq * 256) * 9216 + col;
      float a0 = 0, a1 = 0, a2 = 0;
#pragma unroll 32
      for (int k = 0; k < 256; ++k) {
        float wv = __builtin_nontemporal_load(w + (size_t)k * 9216);
        int kk = kq * 256 + k;
        a0 += sc[kk] * wv; a1 += sc[1024 + kk] * wv; a2 += sc[2048 + kk] * wv;
      }
      red[(0 * 4 + kq) * 64 + cl] = a0; red[(1 * 4 + kq) * 64 + cl] = a1; red[(2 * 4 + kq) * 64 + cl] = a2;
      __syncthreads();
      if (tid < 192) {
        int c = tid >> 6;
        float s = red[(c * 4 + 0) * 64 + cl] + red[(c * 4 + 1) * 64 + cl] + red[(c * 4 + 2) * 64 + cl] + red[(c * 4 + 3) * 64 + cl];
        mods[((size_t)i * 3 + c) * 9216 + col] = s + p.b_ada[(size_t)i * 9216 + col];
      }
      __syncthreads();
    }
    __syncthreads();
  }
  {
    float* tl = (float*)smem;
    for (int t0 = bid * 4; t0 < NTJ; t0 += nb * 4) {
      float4 v[4][4];
      u16* dsts[4]; int Ks_[4], rows[4], k0s[4];
#pragma unroll
      for (int u = 0; u < 4; ++u) {
        const float* src; u16* dst; int K, N, F, id;
        tjob(p, t0 + u, src, dst, K, N, F, id);
        int ntn = N >> 6;
        int kt = id / ntn, ntl = id % ntn;
        int k0 = kt * 64, n0 = ntl * 64;
#pragma unroll
        for (int r = 0; r < 4; ++r) {
          int kk = (tid >> 4) + 16 * r, nn = (tid & 15) * 4;
          v[u][r] = ld_nt((const float4*)(src + (size_t)(k0 + kk) * N + n0 + nn));
        }
        int n = n0 + (tid >> 2), row = n;
        if (F) { int which = n >= F; int j = n - which * F; row = (j >> 4) * 32 + which * 16 + (j & 15); }
        dsts[u] = dst; Ks_[u] = K; rows[u] = row; k0s[u] = k0;
      }
      __syncthreads();
#pragma unroll
      for (int u = 0; u < 4; ++u)
#pragma unroll
        for (int r = 0; r < 4; ++r) {
          int kk = (tid >> 4) + 16 * r, nn = (tid & 15) * 4;
          float* t = tl + u * 64 * 65 + kk * 65 + nn;
          t[0] = v[u][r].x; t[1] = v[u][r].y; t[2] = v[u][r].z; t[3] = v[u][r].w;
        }
      __syncthreads();
#pragma unroll
      for (int u = 0; u < 4; ++u) {
        int nn = tid >> 2, q = tid & 3;
        u16 o[16];
#pragma unroll
        for (int i = 0; i < 16; ++i) o[i] = f2bf(tl[u * 64 * 65 + (q * 16 + i) * 65 + nn]);
        uint4 v0, v1;
        v0.x = o[0] | ((unsigned)o[1] << 16); v0.y = o[2] | ((unsigned)o[3] << 16); v0.z = o[4] | ((unsigned)o[5] << 16); v0.w = o[6] | ((unsigned)o[7] << 16);
        v1.x = o[8] | ((unsigned)o[9] << 16); v1.y = o[10] | ((unsigned)o[11] << 16); v1.z = o[12] | ((unsigned)o[13] << 16); v1.w = o[14] | ((unsigned)o[15] << 16);
        uint4* d4 = (uint4*)(dsts[u] + (size_t)rows[u] * Ks_[u] + k0s[u] + q * 16);
        d4[0] = v0; d4[1] = v1;
      }
    }
  }
}

DEVI void rn_phase(const P& p, int pi, int ps, int ni, int ns, bool hf, int bid, int nb, const int tidx) {
  const int wave = tidx >> 6, lane = tidx & 63;
  float* X = p.out;
  const float* Y = (const float*)(p.ws + OFF_Y);
  const float* mods = (const float*)(p.ws + OFF_MODS);
  u16* H = (u16*)(p.ws + OFF_H);
  float* HF = (float*)(p.ws + OFF_MIX + MX_HF);
  constexpr int NT = 4;
  for (int t0 = (bid * 4 + wave) * NT; t0 < T; t0 += nb * 4 * NT) {
    const int cnd = t0 < TC ? 0 : 1 + ((t0 - TC) >> 12);
    float4 x[NT][4];
#pragma unroll
    for (int u = 0; u < NT; ++u)
#pragma unroll
      for (int r = 0; r < 4; ++r) x[u][r] = *(const float4*)(X + (size_t)(t0 + u) * 1024 + r * 256 + lane * 4);
    if (pi >= 0) {
      float4 y[NT][4];
      float ss[NT];
#pragma unroll
      for (int u = 0; u < NT; ++u) {
        ss[u] = 0.f;
#pragma unroll
        for (int r = 0; r < 4; ++r) {
          const uint2 yb = *(const uint2*)((const u16*)Y + (size_t)(t0 + u) * 1024 + r * 256 + lane * 4);
          y[u][r] = make_float4(__uint_as_float(yb.x << 16), __uint_as_float(yb.x & 0xffff0000u), __uint_as_float(yb.y << 16), __uint_as_float(yb.y & 0xffff0000u));
          ss[u] += y[u][r].x * y[u][r].x + y[u][r].y * y[u][r].y + y[u][r].z * y[u][r].z + y[u][r].w * y[u][r].w;
        }
      }
#pragma unroll
      for (int o = 32; o; o >>= 1)
#pragma unroll
        for (int u = 0; u < NT; ++u) ss[u] += __shfl_xor(ss[u], o);
      const float* g = p.norm_g + (size_t)(pi * 6 + 2 * ps + 1) * 1024;
      const float* gate = mods + ((size_t)(pi * 3 + cnd) * 9 + 3 * ps + 2) * 1024;
      const float wgt = ps == 1 ? 1.f : 0.5f;
#pragma unroll
      for (int r = 0; r < 4; ++r) {
        const int e = r * 256 + lane * 4;
        float4 gg = *(const float4*)(g + e), ga = *(const float4*)(gate + e);
        gg.x *= wgt * ga.x; gg.y *= wgt * ga.y; gg.z *= wgt * ga.z; gg.w *= wgt * ga.w;
#pragma unroll
        for (int u = 0; u < NT; ++u) {
          const float rinv = rsqrtf(ss[u] * (1.f / 1024.f) + 1e-6f);
          x[u][r].x += gg.x * (y[u][r].x * rinv);
          x[u][r].y += gg.y * (y[u][r].y * rinv);
          x[u][r].z += gg.z * (y[u][r].z * rinv);
          x[u][r].w += gg.w * (y[u][r].w * rinv);
          *(float4*)(X + (size_t)(t0 + u) * 1024 + e) = x[u][r];
        }
      }
    }
    if (ni >= 0) {
      float ss[NT];
#pragma unroll
      for (int u = 0; u < NT; ++u) {
        ss[u] = 0.f;
#pragma unroll
        for (int r = 0; r < 4; ++r) ss[u] += x[u][r].x * x[u][r].x + x[u][r].y * x[u][r].y + x[u][r].z * x[u][r].z + x[u][r].w * x[u][r].w;
      }
#pragma unroll
      for (int o = 32; o; o >>= 1)
#pragma unroll
        for (int u = 0; u < NT; ++u) ss[u] += __shfl_xor(ss[u], o);
      const float* g = p.norm_g + (size_t)(ni * 6 + 2 * ns) * 1024;
      const float* sh = mods + ((size_t)(ni * 3 + cnd) * 9 + 3 * ns) * 1024;
      const float* scl = sh + 1024;
#pragma unroll
      for (int r = 0; r < 4; ++r) {
        const int e = r * 256 + lane * 4;
        float4 gg = *(const float4*)(g + e), s4 = *(const float4*)(sh + e), c4 = *(const float4*)(scl + e);
        gg.x *= 1.f + c4.x; gg.y *= 1.f + c4.y; gg.z *= 1.f + c4.z; gg.w *= 1.f + c4.w;
#pragma unroll
        for (int u = 0; u < NT; ++u) {
          const float rinv = rsqrtf(ss[u] * (1.f / 1024.f) + 1e-6f);
          float4 h;
          h.x = x[u][r].x * rinv * gg.x + s4.x;
          h.y = x[u][r].y * rinv * gg.y + s4.y;
          h.z = x[u][r].z * rinv * gg.z + s4.z;
          h.w = x[u][r].w * rinv * gg.w + s4.w;
          uint2 hb;
          hb.x = f2bf(h.x) | ((unsigned)f2bf(h.y) << 16);
          hb.y = f2bf(h.z) | ((unsigned)f2bf(h.w) << 16);
          *(uint2*)(H + (size_t)(t0 + u) * 1024 + e) = hb;
          if (hf) *(float4*)(HF + (size_t)(t0 + u) * 1024 + e) = h;
        }
      }
    }
  }
}

enum { EPI_F32 = 0, EPI_SWIGLU = 1, EPI_GLU = 2, EPI_ROPE = 3, EPI_SPLIT = 4, EPI_YBF = 5 };
constexpr int GBUF = 28672;

DEVI void gemm_phase(const u16* A, int lda, const u16* Bt, int K, int N, int epi,
                     float* of, int ldc, u16* oh, float* of2, int bid, int nb, char* smem, const int tidx) {
  const int tid = tidx, wid = tid >> 6, lane = tid & 63, wr = wid >> 1, wc = wid & 1, fr = lane & 15, fq = lane >> 4;
  lda = __builtin_amdgcn_readfirstlane(lda); K = __builtin_amdgcn_readfirstlane(K); N = __builtin_amdgcn_readfirstlane(N);
  epi = __builtin_amdgcn_readfirstlane(epi); ldc = __builtin_amdgcn_readfirstlane(ldc);
  const int ntn = N >> 8, ntiles = 64 * ntn, nk = K >> 5;
  const int s_row = tid >> 2, s_k = ((tid & 3) ^ ((0x78 >> (2 * ((tid >> 4) & 3))) & 3)) * 8;
  const int r_swz = (fq ^ ((0x78 >> (2 * ((fr >> 2) & 3))) & 3)) * 16;
  const int a_off = (wr * 96 + fr) * 64 + r_swz;
  const int b_off = 12288 + (wc * 128 + fr) * 64 + r_swz;
  uint4 r00, r01, r02, r03, r04, r05, r06, r10, r11, r12, r13, r14, r15, r16;
  uint4 r20, r21, r22, r23, r24, r25, r26, r30, r31, r32, r33, r34, r35, r36;
  const u16 *Ag, *Bg;
  unsigned ao0, ao1, ao2, bo0, bo1, bo2, bo3;
#define TILE_SETUP(tl)                                                                                    \
  do {                                                                                                    \
    const int br_ = ((tl) & 63) * 192, bc_ = ((tl) >> 6) * 256;                                           \
    Ag = A + (size_t)(br_ + s_row) * lda + s_k;                                                           \
    Bg = Bt + (size_t)(bc_ + s_row) * K + s_k;                                                            \
    ao0 = (unsigned)(((br_ + s_row) * lda + s_k) * 2); ao1 = ao0 + (unsigned)(128 * lda); ao2 = ao0 + (unsigned)(256 * lda);   \
    bo0 = (unsigned)(((bc_ + s_row) * K + s_k) * 2); bo1 = bo0 + (unsigned)(128 * K); bo2 = bo0 + (unsigned)(256 * K); bo3 = bo0 + (unsigned)(384 * K); \
  } while (0)
#define GLOAD(r, kt)                                                                                      \
  do {                                                                                                    \
    r##0 = *(const uint4*)(Ag + (kt) * 32);                                                               \
    r##1 = *(const uint4*)(Ag + (size_t)64 * lda + (kt) * 32);                                            \
    r##2 = *(const uint4*)(Ag + (size_t)128 * lda + (kt) * 32);                                           \
    r##3 = *(const uint4*)(Bg + (kt) * 32);                                                               \
    r##4 = *(const uint4*)(Bg + (size_t)64 * K + (kt) * 32);                                              \
    r##5 = *(const uint4*)(Bg + (size_t)128 * K + (kt) * 32);                                             \
    r##6 = *(const uint4*)(Bg + (size_t)192 * K + (kt) * 32);                                             \
  } while (0)
  if (bid < ntiles) { TILE_SETUP(bid); GLOAD(r0, 0); GLOAD(r1, 1); GLOAD(r2, 2); GLOAD(r3, 3); }
  for (int tile = bid; tile < ntiles; tile += nb) {
    const int tn = tile >> 6, tm = tile & 63;
    const int brow = tm * 192, bcol = tn * 256;
    f32x4 acc[6][8];
#pragma unroll
    for (int m = 0; m < 6; ++m)
#pragma unroll
      for (int n = 0; n < 8; ++n) acc[m][n] = f32x4{0.f, 0.f, 0.f, 0.f};
#define LDFRAG(buf, fa, fb)                                                                               \
  do {                                                                                                    \
    const char* sb_ = smem + (buf) * GBUF;                                                                \
    _Pragma("unroll") for (int n_ = 0; n_ < 8; ++n_) fb[n_] = *(const bf16x8*)(sb_ + b_off + n_ * 1024);  \
    _Pragma("unroll") for (int m_ = 0; m_ < 6; ++m_) fa[m_] = *(const bf16x8*)(sb_ + a_off + m_ * 1024);  \
  } while (0)
#define SWRITE(r, buf)                                                                                    \
  do {                                                                                                    \
    char* sb_ = smem + (buf) * GBUF + tid * 16;                                                           \
    *(uint4*)(sb_) = r##0; *(uint4*)(sb_ + 4096) = r##1; *(uint4*)(sb_ + 8192) = r##2;                    \
    *(uint4*)(sb_ + 12288) = r##3; *(uint4*)(sb_ + 16384) = r##4; *(uint4*)(sb_ + 20480) = r##5; *(uint4*)(sb_ + 24576) = r##6; \
  } while (0)
#define LBAR() do { asm volatile("s_waitcnt lgkmcnt(0)" ::: "memory"); __builtin_amdgcn_s_barrier(); asm volatile("" ::: "memory"); } while (0)
#define SB() __builtin_amdgcn_sched_barrier(0)
#define MF(m, n, fa, fb) asm volatile("v_mfma_f32_16x16x32_bf16 %0, %1, %2, %0" : "+a"(acc[m][n]) : "v"(fa[m]), "v"(fb[n]))
#define STEP(ca, cb, na, nb_, rb, rl, kl, rw, wb)  \
  do {  \
    const char* sr_ = smem + (rb) * GBUF;  \
    char* sw_ = smem + (wb) * GBUF + tid * 16;  \
    const char* ab_ = (const char*)A + (size_t)(kl) * 64;  \
    const char* bb_ = (const char*)Bt + (size_t)(kl) * 64;  \
    nb_[0] = *(const bf16x8*)(sr_ + b_off + 0); SB();  \
    MF(0, 0, ca, cb); MF(0, 1, ca, cb); SB();  \
    nb_[1] = *(const bf16x8*)(sr_ + b_off + 1024); SB();  \
    MF(0, 2, ca, cb); MF(0, 3, ca, cb); SB();  \
    rl##0 = *(const uint4*)(ab_ + ao0); SB();  \
    MF(0, 4, ca, cb); MF(0, 5, ca, cb); SB();  \
    nb_[2] = *(const bf16x8*)(sr_ + b_off + 2048); SB();  \
    MF(0, 6, ca, cb); MF(0, 7, ca, cb); SB();  \
    *(uint4*)(sw_ + 0) = rw##0; SB();  \
    MF(1, 0, ca, cb); MF(1, 1, ca, cb); SB();  \
    nb_[3] = *(const bf16x8*)(sr_ + b_off + 3072); SB();  \
    MF(1, 2, ca, cb); MF(1, 3, ca, cb); SB();  \
    rl##1 = *(const uint4*)(ab_ + ao1); SB();  \
    MF(1, 4, ca, cb); MF(1, 5, ca, cb); SB();  \
    nb_[4] = *(const bf16x8*)(sr_ + b_off + 4096); SB();  \
    MF(1, 6, ca, cb); MF(1, 7, ca, cb); SB();  \
    *(uint4*)(sw_ + 4096) = rw##1; SB();  \
    MF(2, 0, ca, cb); MF(2, 1, ca, cb); SB();  \
    nb_[5] = *(const bf16x8*)(sr_ + b_off + 5120); SB();  \
    MF(2, 2, ca, cb); MF(2, 3, ca, cb); SB();  \
    rl##2 = *(const uint4*)(ab_ + ao2); SB();  \
    MF(2, 4, ca, cb); MF(2, 5, ca, cb); SB();  \
    nb_[6] = *(const bf16x8*)(sr_ + b_off + 6144); SB();  \
    MF(2, 6, ca, cb); MF(2, 7, ca, cb); SB();  \
    *(uint4*)(sw_ + 8192) = rw##2; SB();  \
    MF(3, 0, ca, cb); MF(3, 1, ca, cb); SB();  \
    nb_[7] = *(const bf16x8*)(sr_ + b_off + 7168); SB();  \
    MF(3, 2, ca, cb); MF(3, 3, ca, cb); SB();  \
    rl##3 = *(const uint4*)(bb_ + bo0); SB();  \
    MF(3, 4, ca, cb); MF(3, 5, ca, cb); SB();  \
    na[0] = *(const bf16x8*)(sr_ + a_off + 0); SB();  \
    MF(3, 6, ca, cb); MF(3, 7, ca, cb); SB();  \
    *(uint4*)(sw_ + 12288) = rw##3; SB();  \
    MF(4, 0, ca, cb); MF(4, 1, ca, cb); SB();  \
    na[1] = *(const bf16x8*)(sr_ + a_off + 1024); SB();  \
    MF(4, 2, ca, cb); MF(4, 3, ca, cb); SB();  \
    rl##4 = *(const uint4*)(bb_ + bo1); SB();  \
    MF(4, 4, ca, cb); MF(4, 5, ca, cb); SB();  \
    na[2] = *(const bf16x8*)(sr_ + a_off + 2048); SB();  \
    MF(4, 6, ca, cb); MF(4, 7, ca, cb); SB();  \
    *(uint4*)(sw_ + 16384) = rw##4; na[3] = *(const bf16x8*)(sr_ + a_off + 3072); SB();  \
    MF(5, 0, ca, cb); MF(5, 1, ca, cb); SB();  \
    rl##5 = *(const uint4*)(bb_ + bo2); na[4] = *(const bf16x8*)(sr_ + a_off + 4096); SB();  \
    MF(5, 2, ca, cb); MF(5, 3, ca, cb); SB();  \
    *(uint4*)(sw_ + 20480) = rw##5; na[5] = *(const bf16x8*)(sr_ + a_off + 5120); SB();  \
    MF(5, 4, ca, cb); MF(5, 5, ca, cb); SB();  \
    rl##6 = *(const uint4*)(bb_ + bo3); *(uint4*)(sw_ + 24576) = rw##6; SB();  \
    MF(5, 6, ca, cb); MF(5, 7, ca, cb); SB();  \
  } while (0)
    bf16x8 a0[6], b0[8], a1[6], b1[8];
    LBAR();
    SWRITE(r0, 0);
    SWRITE(r1, 1);
    LBAR();
    LDFRAG(0, a0, b0);
#define KCL(x) ((x) < nk ? (x) : nk - 1)
    for (int kt = 0; kt < nk; kt += 4) {
      STEP(a0, b0, a1, b1, 1, r0, KCL(kt + 4), r2, 0);
      LBAR();
      STEP(a1, b1, a0, b0, 0, r1, KCL(kt + 5), r3, 1);
      LBAR();
      STEP(a0, b0, a1, b1, 1, r2, KCL(kt + 6), r0, 0);
      LBAR();
      STEP(a1, b1, a0, b0, 0, r3, KCL(kt + 7), r1, 1);
      LBAR();
    }
#undef KCL
    if (tile + nb < ntiles) { TILE_SETUP(tile + nb); GLOAD(r0, 0); GLOAD(r1, 1); GLOAD(r2, 2); GLOAD(r3, 3); }
#undef LDFRAG
#undef SWRITE
#undef STEP
#undef MF
    asm volatile("s_nop 15");
    asm volatile("s_nop 15");
    {
      float* ep = (float*)smem + wid * (32 * 132);
      const int col0 = bcol + wc * 128;
      float* dst = of; int ld = ldc; int cb = col0;
      if (epi == EPI_SPLIT) { if (bcol < 2048) { ld = 2048; } else { dst = of2; ld = 1280; cb = col0 - 2048; } }
      const float inv = exp2f(-(float)(lane & 15) * (13.287712379549449f / 16.f));
      auto epi_pass = [&](const f32x4 (&ac0)[8], const f32x4 (&ac1)[8], const int q) __attribute__((always_inline)) {
#pragma unroll
        for (int n = 0; n < 8; ++n)
#pragma unroll
          for (int j = 0; j < 4; ++j) {
            ep[(fq * 4 + j) * 132 + n * 16 + fr] = ac0[n][j];
            ep[(16 + fq * 4 + j) * 132 + n * 16 + fr] = ac1[n][j];
          }
        asm volatile("s_waitcnt lgkmcnt(0)" ::: "memory");
        const int grow0 = brow + wr * 96 + q * 32;
        if (epi == EPI_F32 || epi == EPI_SPLIT) {
#pragma unroll 4
          for (int r = 0; r < 32; ++r) {
            float2 v = *(const float2*)(ep + r * 132 + lane * 2);
            __builtin_nontemporal_store(v.x, dst + (size_t)(grow0 + r) * ld + cb + lane * 2); __builtin_nontemporal_store(v.y, dst + (size_t)(grow0 + r) * ld + cb + lane * 2 + 1);
          }
        } else if (epi == EPI_YBF) {
          u16* yb = (u16*)of;
#pragma unroll 4
          for (int r = 0; r < 32; ++r) {
            float2 v = *(const float2*)(ep + r * 132 + lane * 2);
            __builtin_nontemporal_store(pk2bf(v.x, v.y), (unsigned*)(yb + (size_t)(grow0 + r) * 1024 + col0 + lane * 2));
          }
        } else if (epi == EPI_SWIGLU) {
          const int oc = (lane & 31) * 2, ci = (oc >> 4) * 32 + (oc & 15), rh = lane >> 5;
#pragma unroll 4
          for (int r = 0; r < 32; r += 2) {
            const float2 g = *(const float2*)(ep + (r + rh) * 132 + ci), u = *(const float2*)(ep + (r + rh) * 132 + ci + 16);
            const float o0 = g.x * __builtin_amdgcn_rcpf(1.f + __expf(-g.x)) * u.x;
            const float o1 = g.y * __builtin_amdgcn_rcpf(1.f + __expf(-g.y)) * u.y;
            __builtin_nontemporal_store(pk2bf(o0, o1), (unsigned*)(oh + (size_t)(grow0 + r + rh) * DFF + (col0 >> 1) + oc));
          }
        } else if (epi == EPI_GLU) {
          const int oc = (lane & 31) * 2, ci = (oc >> 4) * 32 + (oc & 15), rh = lane >> 5;
#pragma unroll 4
          for (int r = 0; r < 32; r += 2) {
            const float2 a_ = *(const float2*)(ep + (r + rh) * 132 + ci), gt = *(const float2*)(ep + (r + rh) * 132 + ci + 16);
            const float o0 = a_.x * __builtin_amdgcn_rcpf(1.f + __expf(-gt.x));
            const float o1 = a_.y * __builtin_amdgcn_rcpf(1.f + __expf(-gt.y));
            __builtin_nontemporal_store(pk2bf(o0, o1), (unsigned*)((u16*)of + (size_t)(grow0 + r + rh) * 1024 + (col0 >> 1) + oc));
          }
        } else {
          const int hh = lane >> 5, sub = (lane >> 4) & 1, f = lane & 15;
          const int c0 = col0 + hh * 64;
          for (int r = 0; r < 32; ++r) {
            float x1 = ep[r * 132 + hh * 64 + sub * 32 + f], x2 = ep[r * 132 + hh * 64 + sub * 32 + 16 + f];
            const int row = grow0 + r;
            if (row >= TC && c0 < 1280) {
              int pos = (row - TC) & 4095;
              float ang = (float)(sub ? (pos & 63) : (pos >> 6)) * inv;
              float sn = __sinf(ang), cs = __cosf(ang);
              float n1 = x1 * cs - x2 * sn, n2 = x2 * cs + x1 * sn;
              x1 = n1; x2 = n2;
            }
            float* o = of + (size_t)row * 1536 + c0 + sub * 32 + f;
            o[0] = x1; o[16] = x2;
          }
        }
        asm volatile("s_waitcnt lgkmcnt(0)" ::: "memory");
      };
      epi_pass(acc[0], acc[1], 0);
      epi_pass(acc[2], acc[3], 1);
      epi_pass(acc[4], acc[5], 2);
    }
  }
#undef GLOAD
#undef TILE_SETUP
}

DEVI void attn_phase(const P& p, int kind, int bid, int nb, char* smem, const int tidx) {
  const int tid = tidx, wid = tid >> 6, lane = tid & 63, fr = lane & 15, fq = lane >> 4;
  const float* QKV = (const float*)(p.ws + OFF_MIX);
  const int ld = kind == 0 ? 1536 : 3072;
  u16* ACT = (u16*)(p.ws + OFF_ACT);
  {
    if (kind == 0) {
      float* ok = p.out + OUT_AK;
      float* ov = p.out + OUT_AV;
      for (int i = bid * 256 + tid; i < TC * 128; i += nb * 256) {
        int tok = i >> 7, c4 = (i & 127) * 4;
        float4 v = *(const float4*)(QKV + (size_t)tok * 1536 + 1024 + c4);
        if (c4 < 256) *(float4*)(ok + (size_t)tok * 256 + c4) = v; else *(float4*)(ov + (size_t)tok * 256 + c4 - 256) = v;
      }
    } else {
      float* ok = p.out + OUT_NK;
      float* ov = p.out + OUT_NV;
      for (int i = bid * 256 + tid; i < TC * 512; i += nb * 256) {
        int tok = i >> 9, c4 = (i & 511) * 4;
        float4 v = *(const float4*)(QKV + (size_t)tok * 3072 + 1024 + c4);
        if (c4 < 1024) *(float4*)(ok + (size_t)tok * 1024 + c4) = v; else *(float4*)(ov + (size_t)tok * 1024 + c4 - 1024) = v;
      }
    }
  }
  u16* Ks = (u16*)smem;
  u16* Vt = Ks + 2 * 64 * 72;
  u16* Ps = Vt + 2 * 64 * 72;
  u16* Pw = Ps + wid * 32 * 72;
  for (int it = bid; it < 1536; it += nb) {
    const bool lat = it < 1024;
    int b, h, qt;
    if ((nb & 7) == 0) {
      const int x = it & 7;
      if (lat) { const int j = it >> 3; h = 2 * x + (j & 1); b = (j >> 1) & 1; qt = j >> 2; }
      else { const int j = (it - 1024) >> 3; h = 2 * x + (j & 1); qt = (j >> 1) & 1; b = j >> 2; }
    } else if (lat) { b = it >> 9; h = (it >> 5) & 15; qt = it & 31; }
    else { int j = it - 1024; b = j >> 5; h = (j >> 1) & 15; qt = j & 1; }
    const int seqbase = lat ? TC + b * 4096 : b * 256;
    const int q0 = qt * 128;
    int kcol, vcol, cstride;
    const float *cK, *cV;
    if (kind == 0) {
      int kvh = h >> 2;
      kcol = 1024 + kvh * 64; vcol = 1280 + kvh * 64; cstride = 256;
      cK = p.cache_ak + ((size_t)b * 512 * 4 + kvh) * 64; cV = p.cache_av + ((size_t)b * 512 * 4 + kvh) * 64;
    } else {
      kcol = 1024 + h * 64; vcol = 2048 + h * 64; cstride = 1024;
      cK = p.cache_nk + ((size_t)b * 512 * 16 + h) * 64; cV = p.cache_nv + ((size_t)b * 512 * 16 + h) * 64;
    }
    int nloc, lo = 0, rs0 = 0;
    const int rq = 2 * qt + (wid >> 1);
    int rsq = rq - 4; rsq = rsq < 0 ? 0 : (rsq > 56 ? 56 : rsq);
    if (!lat) { nloc = 4; lo = 0; }
    else if (kind == 0) { lo = q0 - 128 < 0 ? 0 : q0 - 128; int hi = q0 + 256 > 4096 ? 4096 : q0 + 256; nloc = (hi - lo) >> 6; }
    else {
      rs0 = 2 * qt - 4; rs0 = rs0 < 0 ? 0 : (rs0 > 56 ? 56 : rs0);
      int rs1 = 2 * qt - 3; rs1 = rs1 < 0 ? 0 : (rs1 > 56 ? 56 : rs1);
      nloc = rs1 + 8 - rs0; lo = rs0 * 64;
    }
    const int ntile = nloc + (lat ? 8 : 0);
    bf16x8 qf[2][2];
#pragma unroll
    for (int mi = 0; mi < 2; ++mi) {
      const float* qp = QKV + (size_t)(seqbase + q0 + wid * 32 + mi * 16 + fr) * ld + h * 64 + fq * 8;
#pragma unroll
      for (int ks = 0; ks < 2; ++ks) {
        float4 a0 = *(const float4*)(qp + ks * 32), a1 = *(const float4*)(qp + ks * 32 + 4);
        const float qs = 0.125f * 1.4426950408889634f;
        float v[8] = {a0.x * qs, a0.y * qs, a0.z * qs, a0.w * qs, a1.x * qs, a1.y * qs, a1.z * qs, a1.w * qs};
        qf[mi][ks] = pack8(v);
      }
    }
    f32x4 o[2][4];
    float mrow[2][4], lrow[2][4];
#pragma unroll
    for (int mi = 0; mi < 2; ++mi)
#pragma unroll
      for (int n = 0; n < 4; ++n) { o[mi][n] = f32x4{0.f, 0.f, 0.f, 0.f}; mrow[mi][n] = -1e30f; lrow[mi][n] = 0.f; }
    float4 kreg[4], vreg[4];
#define ATT_LOAD(ti_)                                                                                      \
  do {                                                                                                     \
    const float *kp_, *vp_; int st_;                                                                       \
    if ((ti_) < nloc) { size_t tok0 = seqbase + lo + (ti_) * 64; kp_ = QKV + tok0 * ld + kcol; vp_ = QKV + tok0 * ld + vcol; st_ = ld; } \
    else { int m0 = ((ti_) - nloc) * 64; kp_ = cK + (size_t)m0 * cstride; vp_ = cV + (size_t)m0 * cstride; st_ = cstride; }          \
    _Pragma("unroll") for (int i = 0; i < 4; ++i) {                                                        \
      int idx = tid + 256 * i; int row = idx >> 4, c4 = (idx & 15) * 4;                                    \
      kreg[i] = *(const float4*)(kp_ + (size_t)row * st_ + c4);                                            \
      vreg[i] = *(const float4*)(vp_ + (size_t)(4 * (tid >> 4) + i) * st_ + c4);     \
    }                                                                                                      \
  } while (0)
#define ATT_STORE(buf_)                                                                                    \
  do {                                                                                                     \
    u16* ks_ = Ks + (buf_) * 64 * 72; u16* vt_ = Vt + (buf_) * 64 * 72;                                    \
    _Pragma("unroll") for (int i = 0; i < 4; ++i) {                                                        \
      int idx = tid + 256 * i; int row = idx >> 4, c4 = (idx & 15) * 4;                                    \
      uint2 kb; kb.x = pk2bf(kreg[i].x, kreg[i].y); kb.y = pk2bf(kreg[i].z, kreg[i].w);                    \
      *(uint2*)(ks_ + row * 72 + c4) = kb;                                                                 \
    }                                                                                                      \
    {                                                                                                      \
      const int c4 = (tid & 15) * 4, k4 = 4 * (tid >> 4);                                                  \
      uint2 w0, w1, w2, w3;                                                                                \
      w0.x = pk2bf(vreg[0].x, vreg[1].x); w0.y = pk2bf(vreg[2].x, vreg[3].x);                              \
      w1.x = pk2bf(vreg[0].y, vreg[1].y); w1.y = pk2bf(vreg[2].y, vreg[3].y);                              \
      w2.x = pk2bf(vreg[0].z, vreg[1].z); w2.y = pk2bf(vreg[2].z, vreg[3].z);                              \
      w3.x = pk2bf(vreg[0].w, vreg[1].w); w3.y = pk2bf(vreg[2].w, vreg[3].w);                              \
      *(uint2*)(vt_ + (c4 + 0) * 72 + k4) = w0; *(uint2*)(vt_ + (c4 + 1) * 72 + k4) = w1;                  \
      *(uint2*)(vt_ + (c4 + 2) * 72 + k4) = w2; *(uint2*)(vt_ + (c4 + 3) * 72 + k4) = w3;                  \
    }                                                                                                      \
  } while (0)
    const float sink_l2 = kind == 0 ? p.a_sink[h] * 1.4426950408889634f : 0.f;
    float* rpbs = (float*)(smem + 55296);
    if (kind == 1 && lat)
      for (int i = tid; i < 465; i += 256) rpbs[i] = p.na_rpb[(size_t)h * 465 + i] * 1.4426950408889634f;
    ATT_LOAD(0);
    ATT_STORE(0);
    __syncthreads();
    for (int ti = 0; ti < ntile; ++ti) {
      const int cur = ti & 1;
      const bool more = ti + 1 < ntile;
      if (more) ATT_LOAD(ti + 1);
      const u16* ksb = Ks + cur * 64 * 72;
      const u16* vtb = Vt + cur * 64 * 72;
      const bool local = ti < nloc;
      const int key0 = lo + ti * 64;
      bool wave_on = true;
      if (lat && local && kind == 1) { int kr = rs0 + ti; wave_on = kr >= rsq && kr < rsq + 8; }
      if (wave_on) {
        f32x4 s[2][4];
#pragma unroll
        for (int n = 0; n < 4; ++n) {
          bf16x8 kb0 = *(const bf16x8*)(ksb + (n * 16 + fr) * 72 + fq * 8);
          bf16x8 kb1 = *(const bf16x8*)(ksb + (n * 16 + fr) * 72 + 32 + fq * 8);
#pragma unroll
          for (int mi = 0; mi < 2; ++mi) {
            s[mi][n] = __builtin_amdgcn_mfma_f32_16x16x32_bf16(qf[mi][0], kb0, f32x4{0.f, 0.f, 0.f, 0.f}, 0, 0, 0);
            s[mi][n] = __builtin_amdgcn_mfma_f32_16x16x32_bf16(qf[mi][1], kb1, s[mi][n], 0, 0, 0);
          }
        }
        if (lat && local) {
          if (kind == 0) {
            const int qw = q0 + wid * 32;
            if (key0 + 63 - qw > 128 || qw + 31 - key0 > 128)
#pragma unroll
            for (int mi = 0; mi < 2; ++mi)
#pragma unroll
              for (int n = 0; n < 4; ++n)
#pragma unroll
                for (int j = 0; j < 4; ++j) {
                  int kpos = key0 + n * 16 + fr, qpos = q0 + wid * 32 + mi * 16 + fq * 4 + j;
                  int dlt = kpos - qpos; dlt = dlt < 0 ? -dlt : dlt;
                  if (dlt > 128) s[mi][n][j] = -3e30f;
                }
          } else {
            const int drow = (rs0 + ti) - rq + 7;
            const float* rp = rpbs + drow * 31;
#pragma unroll
            for (int mi = 0; mi < 2; ++mi)
#pragma unroll
              for (int n = 0; n < 4; ++n)
#pragma unroll
                for (int j = 0; j < 4; ++j) {
                  int kc = n * 16 + fr, qc = (wid & 1) * 32 + mi * 16 + fq * 4 + j;
                  int cs = qc - 8; cs = cs < 0 ? 0 : (cs > 48 ? 48 : cs);
                  int dc = kc - qc; dc = dc < -15 ? -15 : (dc > 15 ? 15 : dc);
                  bool ok = kc >= cs && kc < cs + 16;
                  s[mi][n][j] = ok ? s[mi][n][j] + rp[dc + 15] : -3e30f;
                }
          }
        }
#pragma unroll
        for (int mi = 0; mi < 2; ++mi)
#pragma unroll
          for (int j = 0; j < 4; ++j) {
            float mx = fmaxf(fmaxf(s[mi][0][j], s[mi][1][j]), fmaxf(s[mi][2][j], s[mi][3][j]));
            mx = rowmax16(mx);
            float mnew = fmaxf(mrow[mi][j], mx);
            float alpha = __builtin_amdgcn_exp2f(mrow[mi][j] - mnew);
            mrow[mi][j] = mnew;
            const float p0 = __builtin_amdgcn_exp2f(s[mi][0][j] - mnew), p1 = __builtin_amdgcn_exp2f(s[mi][1][j] - mnew);
            const float p2 = __builtin_amdgcn_exp2f(s[mi][2][j] - mnew), p3 = __builtin_amdgcn_exp2f(s[mi][3][j] - mnew);
            const unsigned q01 = pk2bf(p0, p1), q23 = pk2bf(p2, p3);
            u16* prow = Pw + (mi * 16 + fq * 4 + j) * 72 + fr;
            prow[0] = (u16)q01; prow[16] = (u16)(q01 >> 16); prow[32] = (u16)q23; prow[48] = (u16)(q23 >> 16);
#pragma unroll
            for (int n = 0; n < 4; ++n) o[mi][n][j] *= alpha;
            lrow[mi][j] = lrow[mi][j] * alpha + ((p0 + p1) + (p2 + p3));
          }
        asm volatile("s_waitcnt lgkmcnt(0)" ::: "memory");
#pragma unroll
        for (int ks = 0; ks < 2; ++ks) {
          bf16x8 pa0 = *(const bf16x8*)(Pw + fr * 72 + ks * 32 + fq * 8);
          bf16x8 pa1 = *(const bf16x8*)(Pw + (16 + fr) * 72 + ks * 32 + fq * 8);
#pragma unroll
          for (int n = 0; n < 4; ++n) {
            bf16x8 vb = *(const bf16x8*)(vtb + (n * 16 + fr) * 72 + ks * 32 + fq * 8);
            o[0][n] = __builtin_amdgcn_mfma_f32_16x16x32_bf16(pa0, vb, o[0][n], 0, 0, 0);
            o[1][n] = __builtin_amdgcn_mfma_f32_16x16x32_bf16(pa1, vb, o[1][n], 0, 0, 0);
          }
        }
      }
      if (more) ATT_STORE(cur ^ 1);
      __syncthreads();
    }
#undef ATT_LOAD
#undef ATT_STORE
#pragma unroll
    for (int mi = 0; mi < 2; ++mi)
#pragma unroll
      for (int j = 0; j < 4; ++j) {
        float l = rowsum16(lrow[mi][j]);
        float scale;
        if (kind == 0) {
          float sk = sink_l2;
          float mf = fmaxf(mrow[mi][j], sk);
          float sc = __builtin_amdgcn_exp2f(mrow[mi][j] - mf);
          l = l * sc + __builtin_amdgcn_exp2f(sk - mf);
          scale = sc / l;
        } else scale = 1.f / l;
        size_t tok = seqbase + q0 + wid * 32 + mi * 16 + fq * 4 + j;
#pragma unroll
        for (int n = 0; n < 4; ++n) ACT[tok * 1024 + h * 64 + n * 16 + fr] = f2bf(o[mi][n][j] * scale);
      }
  }
}

DEVI void s5_coeffs(const P& p, int d, int g, int lane, float& ar, float& ai, float (&bbr)[16], float (&bbi)[16]) {
  size_t pi = ((size_t)d * 64 + g) * 64 + lane;
  float lre = p.lam_re[pi], lim = p.lam_im[pi];
  float dt = expf(p.log_dt[d * 64 + g]);
  float lr = lre * dt, li = lim * dt;
  float er = expf(lr);
  float sn, cs;
  sincosf(li, &sn, &cs);
  ar = er * cs; ai = er * sn;
  float den = lre * lre + lim * lim;
  float fr_ = ((ar - 1.f) * lre + ai * lim) / den;
  float fi_ = (ai * lre - (ar - 1.f) * lim) / den;
  const float4* br = (const float4*)(p.b_re + pi * 16);
  const float4* bi = (const float4*)(p.b_im + pi * 16);
#pragma unroll
  for (int q = 0; q < 4; ++q) {
    float4 r4 = br[q], i4 = bi[q];
    bbr[q * 4 + 0] = fr_ * r4.x - fi_ * i4.x; bbi[q * 4 + 0] = fr_ * i4.x + fi_ * r4.x;
    bbr[q * 4 + 1] = fr_ * r4.y - fi_ * i4.y; bbi[q * 4 + 1] = fr_ * i4.y + fi_ * r4.y;
    bbr[q * 4 + 2] = fr_ * r4.z - fi_ * i4.z; bbi[q * 4 + 2] = fr_ * i4.z + fi_ * r4.z;
    bbr[q * 4 + 3] = fr_ * r4.w - fi_ * i4.w; bbi[q * 4 + 3] = fr_ * i4.w + fi_ * r4.w;
  }
}

DEVI void s5_phase(const P& p, int mode, int bid, int nb, char* smem, const int tidx) {
  const int tid = tidx, wid = tid >> 6, lane = tid & 63, fr = lane & 15, fq = lane >> 4;
  const float* HF = (const float*)(p.ws + OFF_MIX + MX_HF);
  float* YD = (float*)(p.ws + OFF_MIX + MX_YD);
  float* Ere = (float*)(p.ws + OFF_MIX + MX_E);
  float* Eim = Ere + 128 * 32 * 64;
  char* wb = smem + wid * 19456;
  u16* BBs = (u16*)wb;
  float* bus = (float*)(wb + 6144);
  u16* xs = (u16*)(wb + 6144 + 8448);
  const int ngrp = mode == 0 ? 8 : 12;
  const bf16x8 zero8 = {0, 0, 0, 0, 0, 0, 0, 0};
#define WSYNC() asm volatile("s_waitcnt lgkmcnt(0)" ::: "memory")
  for (int it = bid; it < 128 * ngrp; it += nb) {
    int dg, grp;
    if ((nb & 7) == 0) {
      const int x = it & 7, j = it >> 3, dgl = j / ngrp;
      grp = j % ngrp;
      dg = ((dgl >> 3) << 6) | (8 * x + (dgl & 7));
    } else { dg = it / ngrp; grp = it % ngrp; }
    const int d = dg >> 6, g = dg & 63;
    int cs = grp * 4 + wid;
    if (mode == 0) cs += 16;
    const bool lat = cs >= 16;
    const int lc = cs - 16, bl = lc >> 4, ck = lc & 15;
    const int tb = lat ? TC + bl * 4096 + ck * 256 : cs * 256;
    float ar, ai;
    bf16x8 bfr[8];
    {
      float bbr[16], bbi[16];
      s5_coeffs(p, d, g, lane, ar, ai, bbr, bbi);
      WSYNC();
      *(bf16x8*)(BBs + lane * 24) = pack8(bbr);
      *(bf16x8*)(BBs + lane * 24 + 8) = pack8(bbr + 8);
      *(bf16x8*)(BBs + (64 + lane) * 24) = pack8(bbi);
      *(bf16x8*)(BBs + (64 + lane) * 24 + 8) = pack8(bbi + 8);
      WSYNC();
#pragma unroll
      for (int nf = 0; nf < 8; ++nf) bfr[nf] = fq < 2 ? *(const bf16x8*)(BBs + (nf * 16 + fr) * 24 + fq * 8) : zero8;
    }
    float xr = 0.f, xi = 0.f;
    bf16x8 cb[4];
    if (mode == 1) {
      if (lat) {
        size_t si = (((size_t)bl * 2 + d) * 64 + g) * 64 + lane;
        xr = p.s5_sre[si]; xi = p.s5_sim[si];
        float cr = ar, ci = ai;
#pragma unroll
        for (int q = 0; q < 8; ++q) { float nr = cr * cr - ci * ci, ni = 2.f * cr * ci; cr = nr; ci = ni; }
        const size_t eb = ((size_t)dg * 32 + bl * 16) * 64 + lane;
        if (d == 0) {
          for (int j = 0; j < ck; ++j) {
            float er = Ere[eb + j * 64], ei = Eim[eb + j * 64];
            float nr = cr * xr - ci * xi + er, ni = cr * xi + ci * xr + ei;
            xr = nr; xi = ni;
          }
        } else {
          for (int j = 15; j > ck; --j) {
            float er = Ere[eb + j * 64], ei = Eim[eb + j * 64];
            float nr = cr * xr - ci * xi + er, ni = cr * xi + ci * xr + ei;
            xr = nr; xi = ni;
          }
        }
      }
      const float* cre = p.c_re + (((size_t)d * 64 + g) * 16 + fr) * 64;
      const float* cim = p.c_im + (((size_t)d * 64 + g) * 16 + fr) * 64;
#pragma unroll
      for (int ks = 0; ks < 4; ++ks) {
        const float* src = (ks < 2 ? cre : cim) + (ks & 1) * 32 + fq * 8;
        float sg = ks < 2 ? 1.f : -1.f;
        float v[8];
#pragma unroll
        for (int q = 0; q < 8; ++q) v[q] = sg * src[q];
        cb[ks] = pack8(v);
      }
    }
    float4 u0 = make_float4(0.f, 0.f, 0.f, 0.f), u1 = u0;
    if (fq < 2) {
      const float* up = HF + (size_t)(tb + (d ? 255 - fr : fr)) * 1024 + g * 16 + fq * 8;
      u0 = *(const float4*)up; u1 = *(const float4*)(up + 4);
    }
    for (int sub = 0; sub < 16; ++sub) {
      bf16x8 uf;
      { float v[8] = {u0.x, u0.y, u0.z, u0.w, u1.x, u1.y, u1.z, u1.w}; uf = pack8(v); }
      if (sub + 1 < 16 && fq < 2) {
        int s = (sub + 1) * 16 + fr;
        const float* up = HF + (size_t)(tb + (d ? 255 - s : s)) * 1024 + g * 16 + fq * 8;
        u0 = *(const float4*)up; u1 = *(const float4*)(up + 4);
      }
#pragma unroll
      for (int nf = 0; nf < 8; ++nf) {
        f32x4 bu = __builtin_amdgcn_mfma_f32_16x16x32_bf16(uf, bfr[nf], f32x4{0.f, 0.f, 0.f, 0.f}, 0, 0, 0);
#pragma unroll
        for (int j = 0; j < 4; ++j) bus[(fq * 4 + j) * 132 + nf * 16 + fr] = bu[j];
      }
      WSYNC();
#pragma unroll
      for (int t = 0; t < 16; ++t) {
        float bur = bus[t * 132 + lane], bui = bus[t * 132 + 64 + lane];
        float nr = ar * xr - ai * xi + bur, ni = ar * xi + ai * xr + bui;
        xr = nr; xi = ni;
        if (mode == 1) { xs[t * 136 + lane] = f2bf(xr); xs[t * 136 + 64 + lane] = f2bf(xi); }
      }
      if (mode == 1) {
        WSYNC();
        f32x4 acc = f32x4{0.f, 0.f, 0.f, 0.f};
#pragma unroll
        for (int ks = 0; ks < 4; ++ks) {
          bf16x8 a = *(const bf16x8*)(xs + fr * 136 + ks * 32 + fq * 8);
          acc = __builtin_amdgcn_mfma_f32_16x16x32_bf16(a, cb[ks], acc, 0, 0, 0);
        }
#pragma unroll
        for (int j = 0; j < 4; ++j) {
          int s = sub * 16 + fq * 4 + j;
          int tok = tb + (d ? 255 - s : s);
          YD[((size_t)d * T + tok) * 1024 + g * 16 + fr] = acc[j];
        }
      }
      asm volatile("" ::: "memory");
    }
    if (mode == 0) {
      size_t ei = ((size_t)dg * 32 + lc) * 64 + lane;
      Ere[ei] = xr; Eim[ei] = xi;
    } else if (!lat) {
      size_t oi = (((size_t)cs * 2 + d) * 64 + g) * 64 + lane;
      p.out[OUT_SRE + oi] = xr; p.out[OUT_SIM + oi] = xi;
    }
  }
#undef WSYNC
}

DEVI void s5c_phase(const P& p, int bid, int nb, const int tidx) {
  const float* HF = (const float*)(p.ws + OFF_MIX + MX_HF);
  const float* Y0 = (const float*)(p.ws + OFF_MIX + MX_YD);
  const float* Y1 = Y0 + (size_t)T * 1024;
  u16* ACT = (u16*)(p.ws + OFF_ACT);
  for (size_t i = (size_t)bid * 256 + tidx; i < (size_t)T * 256; i += (size_t)nb * 256) {
    int e = (int)(i & 255) * 4;
    float4 a = ld_nt((const float4*)Y0 + i), b = ld_nt((const float4*)Y1 + i), h = ld_nt((const float4*)HF + i), dk = *(const float4*)(p.s5_d + e);
    float v[4] = {a.x + b.x + dk.x * h.x, a.y + b.y + dk.y * h.y, a.z + b.z + dk.z * h.z, a.w + b.w + dk.w * h.w};
    u16 o[4];
#pragma unroll
    for (int q = 0; q < 4; ++q) {
      float x = v[q];
      float t = tanhf(0.7978845608028654f * (x + 0.044715f * x * x * x));
      o[q] = f2bf(0.5f * x * (1.f + t));
    }
    uint2 ob; ob.x = o[0] | ((unsigned)o[1] << 16); ob.y = o[2] | ((unsigned)o[3] << 16);
    ((uint2*)ACT)[i] = ob;
  }
}

DEVI void dna_phase(const P& p, int bid, int nb, const int tidx) {
  const int wave = tidx >> 6, lane = tidx & 63;
  const float* RAW = (const float*)(p.ws + OFF_MIX + MX_RAW);
  const float* ZB = (const float*)(p.ws + OFF_MIX + MX_ZB);
  float* QC = (float*)(p.ws + OFF_MIX + MX_QC);
  float* KC = (float*)(p.ws + OFF_MIX + MX_KC);
  float* VC = (float*)(p.ws + OFF_MIX + MX_VC);
  float* BETA = (float*)(p.ws + OFF_MIX + MX_BETA);
  float* G = (float*)(p.ws + OFF_MIX + MX_G);
  for (int t0 = (bid * 4 + wave) * 4; t0 < T; t0 += nb * 16) {
    int base, L;
    if (t0 < TC) { base = t0 & ~255; L = 256; } else { base = TC + (((t0 - TC) >> 12) << 12); L = 4096; }
    const int pos0 = t0 - base;
#pragma unroll 2
    for (int r = 0; r < 8; ++r) {
      const int ch = r * 256 + lane * 4;
      float4 x[8], w[5];
#pragma unroll
      for (int k = 0; k < 8; ++k) {
        int pp = pos0 - 2 + k;
        x[k] = (pp >= 0 && pp < L) ? *(const float4*)(RAW + (size_t)(base + pp) * 2048 + ch) : make_float4(0.f, 0.f, 0.f, 0.f);
      }
#pragma unroll
      for (int j = 0; j < 5; ++j) w[j] = *(const float4*)(p.dn_conv + (size_t)j * 2048 + ch);
#pragma unroll
      for (int u = 0; u < 4; ++u) {
        float4 a = make_float4(0.f, 0.f, 0.f, 0.f);
#pragma unroll
        for (int j = 0; j < 5; ++j) {
          a.x += w[j].x * x[u + j].x; a.y += w[j].y * x[u + j].y; a.z += w[j].z * x[u + j].z; a.w += w[j].w * x[u + j].w;
        }
        a.x = a.x / (1.f + __expf(-a.x)); a.y = a.y / (1.f + __expf(-a.y)); a.z = a.z / (1.f + __expf(-a.z)); a.w = a.w / (1.f + __expf(-a.w));
        const int t = t0 + u;
        if (r < 4) {
          float ss = a.x * a.x + a.y * a.y + a.z * a.z + a.w * a.w;
          ss += __shfl_xor(ss, 1); ss += __shfl_xor(ss, 2); ss += __shfl_xor(ss, 4); ss += __shfl_xor(ss, 8); ss += __shfl_xor(ss, 16);
          float sc = rsqrtf(ss + 1e-6f);
          if (r < 2) sc *= 0.08838834764831845f;
          a.x *= sc; a.y *= sc; a.z *= sc; a.w *= sc;
          float* dst = r < 2 ? QC + (size_t)t * 512 + ch : KC + (size_t)t * 512 + (ch - 512);
          *(float4*)dst = a;
        } else {
          *(float4*)(VC + (size_t)t * 1024 + (ch - 1024)) = a;
        }
      }
    }
    {
#pragma unroll
      for (int half = 0; half < 2; ++half) {
        const int u = half * 2 + (lane >> 5), idx = lane & 31;
        const int t = t0 + u, d = idx >> 4, rr = idx & 15;
        float raw = ZB[(size_t)t * 1280 + 1024 + d * 16 + rr];
        if (rr < 8) BETA[((size_t)d * T + t) * 8 + rr] = sigmoidf_(raw);
        else {
          int h = rr - 8;
          float xx = raw + p.dn_dtb[d * 8 + h];
          float sp = xx > 20.f ? xx : log1pf(expf(xx));
          G[((size_t)d * T + t) * 8 + h] = -expf(p.dn_alog[d * 8 + h]) * sp;
        }
      }
    }
  }
}

DEVI void dn_cs(int cs, int& base, int& L, int& n) {
  if (cs < 64) { base = (cs >> 2) * 256; L = 256; n = cs & 3; }
  else { int j = cs - 64; base = TC + (j >> 6) * 4096; L = 4096; n = j & 63; }
}

constexpr size_t DN_HALF = (size_t)3072 * 64 * 128 * 2;
DEVI void dnb_phase(const P& p, int bid, int nb, char* smem, const int tidx) {
  const int tid = tidx;
  const float* QC = (const float*)(p.ws + OFF_MIX + MX_QC);
  const float* KC = (const float*)(p.ws + OFF_MIX + MX_KC);
  const float* VC = (const float*)(p.ws + OFF_MIX + MX_VC);
  const float* BETA = (const float*)(p.ws + OFF_MIX + MX_BETA);
  const float* G = (const float*)(p.ws + OFF_MIX + MX_G);
  u16* Ub = (u16*)(p.ws + OFF_MIX + MX_RAW);
  u16* KdT = (u16*)(p.ws + OFF_MIX + MX_RAW + DN_HALF);
  u16* Wb = (u16*)(p.ws + OFF_MIX + MX_W);
  u16* Qg = (u16*)(p.ws + OFF_MIX + MX_W + DN_HALF);
  u16* Ab = (u16*)(p.ws + OFF_ACT + AX_AQK);
  float* GC = (float*)(p.ws + OFF_ACT + AX_GC);
  u16* Kb = (u16*)smem;
  u16* Qb = Kb + 64 * 136;
  float* Lm = (float*)(Qb + 64 * 136);
  float* gcs = Lm + 64 * 64;
  float* bts = gcs + 64;
  int* toks = (int*)(bts + 64);
  float* egs = (float*)(toks + 64);
  float* eds = egs + 64;
  float* sol = eds + 64;
  const int wid = tid >> 6, lane = tid & 63, fr = lane & 15, fq = lane >> 4;
  for (int it0 = bid; it0 < 3072; it0 += nb) {
    const int it = (nb & 7) == 0 ? ((((it0 >> 3) >> 4) * 8 + (it0 & 7)) << 4) | ((it0 >> 3) & 15) : it0;
    const int cs = it >> 4, h = (it >> 1) & 7, d = it & 1, hk = h >> 1;
    int base, L, n;
    dn_cs(cs, base, L, n);
    __syncthreads();
    if (tid < 64) {
      int pos = n * 64 + tid;
      int tok = base + (d ? L - 1 - pos : pos);
      toks[tid] = tok;
      float g = G[((size_t)d * T + tok) * 8 + h];
      bts[tid] = BETA[((size_t)d * T + tok) * 8 + h];
#pragma unroll
      for (int o = 1; o < 64; o <<= 1) { float v = __shfl_up(g, o); if (tid >= o) g += v; }
      gcs[tid] = g;
      GC[(size_t)it * 64 + tid] = g;
      egs[tid] = expf(g);
      eds[tid] = expf(__shfl(g, 63) - g);
    }
    __syncthreads();
#pragma unroll
    for (int i = 0; i < 8; ++i) {
      int idx = tid + 256 * i;
      int row = idx >> 5, c4 = (idx & 31) * 4;
      float4 kv = *(const float4*)(KC + (size_t)toks[row] * 512 + hk * 128 + c4);
      float4 qv = *(const float4*)(QC + (size_t)toks[row] * 512 + hk * 128 + c4);
      uint2 kb, qb, qg;
      kb.x = f2bf(kv.x) | ((unsigned)f2bf(kv.y) << 16); kb.y = f2bf(kv.z) | ((unsigned)f2bf(kv.w) << 16);
      qb.x = f2bf(qv.x) | ((unsigned)f2bf(qv.y) << 16); qb.y = f2bf(qv.z) | ((unsigned)f2bf(qv.w) << 16);
      const float eg = egs[row];
      qg.x = f2bf(qv.x * eg) | ((unsigned)f2bf(qv.y * eg) << 16); qg.y = f2bf(qv.z * eg) | ((unsigned)f2bf(qv.w * eg) << 16);
      *(uint2*)(Kb + row * 136 + c4) = kb;
      *(uint2*)(Qb + row * 136 + c4) = qb;
      *(uint2*)(Qg + ((size_t)it * 64 + row) * 128 + c4) = qg;
    }
    __syncthreads();
    {
      f32x4 kk[4], qk[4];
#pragma unroll
      for (int nn = 0; nn < 4; ++nn) { kk[nn] = f32x4{0.f, 0.f, 0.f, 0.f}; qk[nn] = f32x4{0.f, 0.f, 0.f, 0.f}; }
#pragma unroll
      for (int ks = 0; ks < 4; ++ks) {
        bf16x8 ka = *(const bf16x8*)(Kb + (wid * 16 + fr) * 136 + ks * 32 + fq * 8);
        bf16x8 qa = *(const bf16x8*)(Qb + (wid * 16 + fr) * 136 + ks * 32 + fq * 8);
#pragma unroll
        for (int nn = 0; nn < 4; ++nn) {
          if (nn <= wid) {
            bf16x8 kbf = *(const bf16x8*)(Kb + (nn * 16 + fr) * 136 + ks * 32 + fq * 8);
            kk[nn] = __builtin_amdgcn_mfma_f32_16x16x32_bf16(ka, kbf, kk[nn], 0, 0, 0);
            qk[nn] = __builtin_amdgcn_mfma_f32_16x16x32_bf16(qa, kbf, qk[nn], 0, 0, 0);
          }
        }
      }
      __syncthreads();
      float* LmT = (float*)Qb;
#pragma unroll
      for (int nn = 0; nn < 4; ++nn)
#pragma unroll
        for (int jj = 0; jj < 4; ++jj) {
          const int i = wid * 16 + fq * 4 + jj, j = nn * 16 + fr;
          const float dec = i >= j ? expf(gcs[i] - gcs[j]) : 0.f;
          const float lv = i > j ? bts[i] * kk[nn][jj] * dec : 0.f;
          Lm[i * 64 + j] = lv;
          LmT[j * 64 + i] = lv;
          Ab[((size_t)it * 64 + i) * 64 + j] = f2bf(qk[nn][jj] * dec);
        }
      {
        const int dd = tid >> 1, hf = tid & 1;
        u16* kd = KdT + ((size_t)it * 128 + dd) * 64 + hf * 32;
#pragma unroll
        for (int q8 = 0; q8 < 4; ++q8) {
          float v[8];
#pragma unroll
          for (int q = 0; q < 8; ++q) { int c = hf * 32 + q8 * 8 + q; v[q] = __uint_as_float((unsigned)Kb[c * 136 + dd] << 16) * eds[c]; }
          uint4 o;
          o.x = f2bf(v[0]) | ((unsigned)f2bf(v[1]) << 16); o.y = f2bf(v[2]) | ((unsigned)f2bf(v[3]) << 16);
          o.z = f2bf(v[4]) | ((unsigned)f2bf(v[5]) << 16); o.w = f2bf(v[6]) | ((unsigned)f2bf(v[7]) << 16);
          *(uint4*)(kd + q8 * 8) = o;
        }
      }
    }
    __syncthreads();
    {
      const int c = tid;
      const bool isU = c < 128;
      u16* dst = isU ? Ub + ((size_t)it * 128 + c) * 64 : Wb + (size_t)it * 64 * 128 + (c - 128);
      const float* rsrc = isU ? VC + h * 128 + c : KC + hk * 128 + (c - 128);
      const int rstride = isU ? 1024 : 512;
      float rhs[64];
#pragma unroll
      for (int i = 0; i < 64; ++i) rhs[i] = rsrc[(size_t)toks[i] * rstride];
#pragma unroll
      for (int rb = 0; rb < 4; ++rb) {
        float acc[16];
#pragma unroll
        for (int ii = 0; ii < 16; ++ii) {
          int i = rb * 16 + ii;
          float bt = bts[i];
          float f = isU ? bt : bt * egs[i];
          acc[ii] = rhs[i] * f;
        }
        for (int j = 0; j < rb * 16; ++j) {
          const float s = sol[j * 256 + c];
          const float4* lt = (const float4*)((const float*)Qb + j * 64 + rb * 16);
#pragma unroll
          for (int q4 = 0; q4 < 4; ++q4) {
            const float4 l4 = lt[q4];
            acc[q4 * 4 + 0] -= l4.x * s; acc[q4 * 4 + 1] -= l4.y * s; acc[q4 * 4 + 2] -= l4.z * s; acc[q4 * 4 + 3] -= l4.w * s;
          }
        }
#pragma unroll
        for (int ii = 0; ii < 16; ++ii) {
#pragma unroll
          for (int jj = 0; jj < ii; ++jj) acc[ii] -= Lm[(rb * 16 + ii) * 64 + rb * 16 + jj] * acc[jj];
          sol[(rb * 16 + ii) * 256 + c] = acc[ii];
          if (isU) dst[rb * 16 + ii] = f2bf(acc[ii]);
          else dst[(rb * 16 + ii) * 128] = f2bf(acc[ii]);
        }
      }
    }
  }
}

DEVI void dnc_phase(const P& p, int bid, int nb, char* smem, const int tidx) {
  const int tid = tidx, wid = tid >> 6, lane = tid & 63, fr = lane & 15, fq = lane >> 4;
  const u16* Ub = (const u16*)(p.ws + OFF_MIX + MX_RAW);
  const u16* KdT = (const u16*)(p.ws + OFF_MIX + MX_RAW + DN_HALF);
  const u16* Wb = (const u16*)(p.ws + OFF_MIX + MX_W);
  const u16* Qg = (const u16*)(p.ws + OFF_MIX + MX_W + DN_HALF);
  const u16* Ab = (const u16*)(p.ws + OFF_ACT + AX_AQK);
  const float* GC = (const float*)(p.ws + OFF_ACT + AX_GC);
  float* O0 = (float*)(p.ws + OFF_Y);
  float* O1 = (float*)(p.ws + OFF_MIX + MX_O1);
  u16* St = (u16*)smem;
  u16* Vt = St + 32 * 136;
  int it, nit, step;
  if (nb >= 256) { if (bid < 128) { it = bid; nit = 1; } else if (bid < 256) { it = bid; nit = 8; } else { it = 0; nit = 0; } step = 128; }
  else { it = bid; nit = (1152 - bid + nb - 1) / nb; step = nb; }
  for (int ii = 0; ii < nit; ++ii, it += step) {
    int chain, sq, sl;
    if ((nb & 7) == 0) {
      const int jb = it < 128 ? it : it - 128;
      const int x = jb & 7, j = jb >> 3;
      sl = j & 3;
      chain = (j >> 2) * 8 + x;
    } else { sl = it & 3; chain = it < 128 ? it >> 2 : (it - 128) >> 2; }
    sq = it < 128 ? 16 + (chain >> 4) : chain >> 4;
    const int h = (chain >> 1) & 7, d = chain & 1, e0 = sl * 32;
    const bool lat = sq >= 16;
    const int nch = lat ? 64 : 4;
    const int csb = lat ? 64 + (sq - 16) * 64 : sq * 4;
    const int tokbase = lat ? TC + (sq - 16) * 4096 : sq * 256;
    const int L = lat ? 4096 : 256;
    float* Od = d ? O1 : O0;
    f32x4 S_[2][2];
#pragma unroll
    for (int mi = 0; mi < 2; ++mi)
#pragma unroll
      for (int ni = 0; ni < 2; ++ni) {
        if (lat) {
          const float* s0 = p.state_dn + ((((size_t)(sq - 16) * 2 + d) * 8 + h) * 128) * 128;
#pragma unroll
          for (int j = 0; j < 4; ++j) S_[mi][ni][j] = s0[(size_t)((2 * wid + mi) * 16 + fq * 4 + j) * 128 + e0 + ni * 16 + fr];
        } else S_[mi][ni] = f32x4{0.f, 0.f, 0.f, 0.f};
      }
    __syncthreads();
#pragma unroll
    for (int mi = 0; mi < 2; ++mi)
#pragma unroll
      for (int ni = 0; ni < 2; ++ni) {
        uint2 sv;
        sv.x = f2bf(S_[mi][ni][0]) | ((unsigned)f2bf(S_[mi][ni][1]) << 16);
        sv.y = f2bf(S_[mi][ni][2]) | ((unsigned)f2bf(S_[mi][ni][3]) << 16);
        *(uint2*)(St + (ni * 16 + fr) * 136 + (2 * wid + mi) * 16 + fq * 4) = sv;
      }
    bf16x8 Wf[3][4], Qf[3][4], Af[3][2], Kf[3][2][2];
    uint2 uu[3][2]; float gl[3];
#define DNC_LOAD(nn, S)                                                                                                \
  do {                                                                                                                 \
    const size_t ib_ = ((size_t)(csb + (nn)) * 8 + h) * 2 + d;                                                         \
    _Pragma("unroll") for (int ks = 0; ks < 4; ++ks) {                                                                 \
      Wf[S][ks] = *(const bf16x8*)(Wb + (ib_ * 64 + wid * 16 + fr) * 128 + ks * 32 + fq * 8);                          \
      Qf[S][ks] = *(const bf16x8*)(Qg + (ib_ * 64 + wid * 16 + fr) * 128 + ks * 32 + fq * 8);                          \
    }                                                                                                                  \
    _Pragma("unroll") for (int ks = 0; ks < 2; ++ks) {                                                                 \
      Af[S][ks] = *(const bf16x8*)(Ab + (ib_ * 64 + wid * 16 + fr) * 64 + ks * 32 + fq * 8);                           \
      Kf[S][0][ks] = *(const bf16x8*)(KdT + (ib_ * 128 + (2 * wid) * 16 + fr) * 64 + ks * 32 + fq * 8);                \
      Kf[S][1][ks] = *(const bf16x8*)(KdT + (ib_ * 128 + (2 * wid + 1) * 16 + fr) * 64 + ks * 32 + fq * 8);            \
    }                                                                                                                  \
    _Pragma("unroll") for (int ni = 0; ni < 2; ++ni)                                                                   \
        uu[S][ni] = *(const uint2*)(Ub + (ib_ * 128 + e0 + ni * 16 + fr) * 64 + wid * 16 + fq * 4);                   \
    gl[S] = GC[ib_ * 64 + 63];                                                                                         \
  } while (0)
#define DNC_STEP(n, S)                                                                                                 \
  do {                                                                                                                 \
    const float eg = expf(gl[S]);                                                                                      \
    f32x4 vs[2], o[2];                                                                                                 \
    _Pragma("unroll") for (int ni = 0; ni < 2; ++ni) {                                                                 \
      vs[ni] = f32x4{0.f, 0.f, 0.f, 0.f}; o[ni] = f32x4{0.f, 0.f, 0.f, 0.f};                                           \
      _Pragma("unroll") for (int ks = 0; ks < 4; ++ks) {                                                               \
        bf16x8 sf = *(const bf16x8*)(St + (ni * 16 + fr) * 136 + ks * 32 + fq * 8);                                    \
        vs[ni] = __builtin_amdgcn_mfma_f32_16x16x32_bf16(Wf[S][ks], sf, vs[ni], 0, 0, 0);                              \
        o[ni] = __builtin_amdgcn_mfma_f32_16x16x32_bf16(Qf[S][ks], sf, o[ni], 0, 0, 0);                                \
      }                                                                                                                \
    }                                                                                                                  \
    _Pragma("unroll") for (int ni = 0; ni < 2; ++ni) {                                                                 \
      uint2 vv;                                                                                                        \
      const float u0_ = __uint_as_float(uu[S][ni].x << 16), u1_ = __uint_as_float(uu[S][ni].x & 0xffff0000u);         \
      const float u2_ = __uint_as_float(uu[S][ni].y << 16), u3_ = __uint_as_float(uu[S][ni].y & 0xffff0000u);         \
      vv.x = pk2bf(u0_ - vs[ni][0], u1_ - vs[ni][1]);                                                                  \
      vv.y = pk2bf(u2_ - vs[ni][2], u3_ - vs[ni][3]);                                                                  \
      *(uint2*)(Vt + (ni * 16 + fr) * 72 + wid * 16 + fq * 4) = vv;                                                    \
    }                                                                                                                  \
    LBAR();                                                                                                           \
    bf16x8 vf[2][2];                                                                                                   \
    _Pragma("unroll") for (int ni = 0; ni < 2; ++ni)                                                                   \
    _Pragma("unroll") for (int ks = 0; ks < 2; ++ks) vf[ni][ks] = *(const bf16x8*)(Vt + (ni * 16 + fr) * 72 + ks * 32 + fq * 8); \
    _Pragma("unroll") for (int ni = 0; ni < 2; ++ni) {                                                                 \
      _Pragma("unroll") for (int ks = 0; ks < 2; ++ks) o[ni] = __builtin_amdgcn_mfma_f32_16x16x32_bf16(Af[S][ks], vf[ni][ks], o[ni], 0, 0, 0); \
      _Pragma("unroll") for (int j = 0; j < 4; ++j) {                                                                  \
        int pos = (n) * 64 + wid * 16 + fq * 4 + j;                                                                    \
        int tok = tokbase + (d ? L - 1 - pos : pos);                                                                   \
        __builtin_nontemporal_store(o[ni][j], Od + (size_t)tok * 1024 + h * 128 + e0 + ni * 16 + fr);                  \
      }                                                                                                                \
    }                                                                                                                  \
    _Pragma("unroll") for (int mi = 0; mi < 2; ++mi)                                                                   \
    _Pragma("unroll") for (int ni = 0; ni < 2; ++ni) {                                                                 \
      S_[mi][ni] = S_[mi][ni] * eg;                                                                                    \
      _Pragma("unroll") for (int ks = 0; ks < 2; ++ks) S_[mi][ni] = __builtin_amdgcn_mfma_f32_16x16x32_bf16(Kf[S][mi][ks], vf[ni][ks], S_[mi][ni], 0, 0, 0); \
      uint2 sv;                                                                                                        \
      sv.x = pk2bf(S_[mi][ni][0], S_[mi][ni][1]);                                                                      \
      sv.y = pk2bf(S_[mi][ni][2], S_[mi][ni][3]);                                                                      \
      *(uint2*)(St + (ni * 16 + fr) * 136 + (2 * wid + mi) * 16 + fq * 4) = sv;                                        \
    }                                                                                                                  \
    LBAR();                                                                                                           \
  } while (0)
#define NCL(x) ((x) < nch ? (x) : nch - 1)
    DNC_LOAD(0, 0);
    DNC_LOAD(1, 1);
    __syncthreads();
    int n = 0;
    for (; n + 2 < nch; n += 3) {
      DNC_LOAD(NCL(n + 2), 2); DNC_STEP(n, 0);
      DNC_LOAD(NCL(n + 3), 0); DNC_STEP(n + 1, 1);
      DNC_LOAD(NCL(n + 4), 1); DNC_STEP(n + 2, 2);
    }
    DNC_STEP(n, 0);
#undef NCL
#undef DNC_STEP
#undef DNC_LOAD
    if (!lat) {
      float* dst = p.out + OUT_DN + ((((size_t)sq * 2 + d) * 8 + h) * 128) * 128;
#pragma unroll
      for (int mi = 0; mi < 2; ++mi)
#pragma unroll
        for (int ni = 0; ni < 2; ++ni)
#pragma unroll
          for (int j = 0; j < 4; ++j) dst[(size_t)((2 * wid + mi) * 16 + fq * 4 + j) * 128 + e0 + ni * 16 + fr] = S_[mi][ni][j];
    }
  }
}

DEVI void dnd_phase(const P& p, int bid, int nb, const int tidx) {
  const int wave = tidx >> 6, lane = tidx & 63;
  const float* O0 = (const float*)(p.ws + OFF_Y);
  const float* O1 = (const float*)(p.ws + OFF_MIX + MX_O1);
  const float* ZB = (const float*)(p.ws + OFF_MIX + MX_ZB);
  u16* ACT = (u16*)(p.ws + OFF_ACT);
  const float2 og = *(const float2*)(p.dn_outg + lane * 2);
  for (int t = bid * 4 + wave; t < T; t += nb * 4) {
    float2 av[8], bv[8], zv[8];
#pragma unroll
    for (int h = 0; h < 8; ++h) {
      int ch = h * 128 + lane * 2;
      av[h] = *(const float2*)(O0 + (size_t)t * 1024 + ch);
      bv[h] = *(const float2*)(O1 + (size_t)t * 1024 + ch);
      zv[h] = *(const float2*)(ZB + (size_t)t * 1280 + ch);
    }
#pragma unroll
    for (int h = 0; h < 8; ++h) {
      int ch = h * 128 + lane * 2;
      float o0 = av[h].x + bv[h].x, o1 = av[h].y + bv[h].y;
      float ss = wsum(o0 * o0 + o1 * o1);
      float rinv = rsqrtf(ss * (1.f / 128.f) + 1e-6f);
      float r0 = o0 * rinv * og.x * (zv[h].x / (1.f + __expf(-zv[h].x)));
      float r1 = o1 * rinv * og.y * (zv[h].y / (1.f + __expf(-zv[h].y)));
      *(unsigned*)(ACT + (size_t)t * 1024 + ch) = pk2bf(r0, r1);
    }
  }
}

#define XB_TMO      128
#define XB_XCNT(j)  (256  + 64 * (j))
#define XB_XSUB(j)  (1280 + 64 * (j))
#define XB_XGEN(j)  (2304 + 64 * (j))
#define XB_TOP      3328
#define XB_TOPGEN   3392
#define XCD_BAR_WORDS 3456
#define XB_SPIN_CAP (1u << 18)
#define LAS __attribute__((address_space(3)))
DEVI unsigned xb_ld(unsigned* p) { return __hip_atomic_load(p, __ATOMIC_RELAXED, __HIP_MEMORY_SCOPE_AGENT); }
DEVI unsigned xb_add(unsigned* p, unsigned v) { return __hip_atomic_fetch_add(p, v, __ATOMIC_RELAXED, __HIP_MEMORY_SCOPE_AGENT); }
DEVI unsigned xb_xcc_id() { return (unsigned)__builtin_amdgcn_s_getreg((3 << 11) | 20) & 0xFu; }
#define XB_SPIN(cond, bar) do { unsigned _sp = 0; while (cond) { __builtin_amdgcn_s_sleep(1); \
    if ((++_sp & 255u) == 0u) { if (xb_ld(&(bar)[XB_TMO])) break; if (_sp > XB_SPIN_CAP) { atomicAdd(&(bar)[XB_TMO], 1u); break; } } } } while (0)
struct XcdBarrier { unsigned* bar; unsigned x; volatile LAS unsigned* st; };
DEVI XcdBarrier xcd_barrier_post(unsigned* bar, volatile LAS unsigned* st) {
  XcdBarrier b; b.bar = bar; b.x = xb_xcc_id(); b.st = st;
  if (threadIdx.x == 0) (void)xb_add(&bar[XB_XCNT(b.x)], 1u);
  return b;
}
DEVI void xcd_barrier_complete(unsigned* bar, unsigned x, unsigned& nloc, unsigned& nx) {
  const unsigned G = gridDim.x * gridDim.y * gridDim.z;
  unsigned sum, cnt, mine, sp = 0u;
  for (;;) {
    sum = 0u; cnt = 0u; mine = 0u;
#pragma unroll
    for (unsigned j = 0; j < 16; ++j) { const unsigned c = xb_ld(&bar[XB_XCNT(j)]); sum += c; cnt += (c > 0u) ? 1u : 0u; mine = (j == x) ? c : mine; }
    if (sum == G) break;
    __builtin_amdgcn_s_sleep(1);
    if ((++sp & 255u) == 0u) { if (xb_ld(&bar[XB_TMO])) break; if (sp > XB_SPIN_CAP) { atomicAdd(&bar[XB_TMO], 1u); break; } }
  }
  nloc = mine > 0u ? mine : 1u; nx = cnt > 0u ? cnt : 1u;
}
DEVI void xcd_barrier(const XcdBarrier& b) {
  asm volatile("s_waitcnt vmcnt(0)" ::: "memory");
  __syncthreads();
  if (threadIdx.x == 0) {
    unsigned* bar = b.bar;
    __builtin_amdgcn_s_waitcnt(0);
    unsigned nloc = b.st[0], nx = b.st[1];
    if (nloc == 0u) { xcd_barrier_complete(bar, b.x, nloc, nx); b.st[0] = nloc; b.st[1] = nx; }
    const unsigned old = xb_add(&bar[XB_XSUB(b.x)], 1u);
    const unsigned gen = old / nloc;
    if (old + 1u == (gen + 1u) * nloc) {
      __builtin_amdgcn_fence(__ATOMIC_RELEASE, "agent");
      asm volatile("s_waitcnt vmcnt(0)" ::: "memory");
      const unsigned og = xb_add(&bar[XB_TOP], 1u);
      const unsigned tg = og / nx;
      if (og + 1u == (tg + 1u) * nx) xb_add(&bar[XB_TOPGEN], 1u);
      else XB_SPIN(xb_ld(&bar[XB_TOPGEN]) == tg, bar);
      __builtin_amdgcn_fence(__ATOMIC_ACQUIRE, "agent");
      xb_add(&bar[XB_XGEN(b.x)], 1u);
      asm volatile("s_waitcnt vmcnt(0)" ::: "memory");
    } else {
      XB_SPIN(xb_ld(&bar[XB_XGEN(b.x)]) == gen, bar);
      __builtin_amdgcn_fence(__ATOMIC_ACQUIRE, "agent");
      asm volatile("s_waitcnt vmcnt(0)" ::: "memory");
    }
  }
  __syncthreads();
}

enum { K_PREP = 0, K_RN, K_G1, K_G2, K_ATTN, K_S5A, K_S5B, K_S5C, K_DNA, K_DNB, K_DNC, K_DND };
__constant__ unsigned char PROG[NPH][2] = {
    {K_PREP, 0},
    {K_RN, 0}, {K_G1, 0}, {K_G2, 0},
    {K_RN, 1}, {K_G1, 1}, {K_ATTN, 0}, {K_G2, 1},
    {K_RN, 2}, {K_G1, 2}, {K_G2, 2},
    {K_RN, 3}, {K_G1, 3}, {K_G2, 3},
    {K_RN, 4}, {K_S5A, 0}, {K_S5B, 0}, {K_S5C, 0}, {K_G2, 4},
    {K_RN, 5}, {K_G1, 5}, {K_G2, 5},
    {K_RN, 6}, {K_G1, 6}, {K_G2, 6},
    {K_RN, 7}, {K_G1, 7}, {K_ATTN, 1}, {K_G2, 7},
    {K_RN, 8}, {K_G1, 8}, {K_G2, 8},
    {K_RN, 9}, {K_G1, 9}, {K_G2, 9},
    {K_RN, 10}, {K_G1, 10}, {K_DNA, 0}, {K_DNB, 0}, {K_DNC, 0}, {K_DND, 0}, {K_G2, 10},
    {K_RN, 11}, {K_G1, 11}, {K_G2, 11},
    {K_RN, 12}};

__global__ void __launch_bounds__(256) mega(P pk) {
  extern __shared__ __attribute__((aligned(16))) char smem[];
  cg::grid_group grid = cg::this_grid();
  __shared__ uint4 xb_words;
  if (threadIdx.x == 0) xb_words = make_uint4(0u, 0u, 0u, 0u);
  __syncthreads();
  XcdBarrier xb = xcd_barrier_post((unsigned*)(pk.ws + OFF_BAR), (volatile LAS unsigned*)&xb_words);
  const P& p = pk;
  const int plo = pk.lo, phi = pk.hi;
  for (int ph = plo; ph < phi; ++ph) {
    int tidx = threadIdx.x, bid = blockIdx.x, nb = gridDim.x;
    asm volatile("" : "+s"(bid), "+s"(nb));
    asm volatile("" : "+v"(tidx));
    char* ws = p.ws;
    const int kind = PROG[ph][0], arg = PROG[ph][1];
    if (kind == K_G1 || kind == K_G2) {
      const int i = arg / 3, s = arg % 3;
      const u16* A; const u16* Wt; int lda = 1024, K = 1024, N = 1024, epi = (kind == K_G1 ? EPI_F32 : EPI_YBF), ldc = 1024;
      float* of = (float*)(ws + OFF_Y); float* of2 = nullptr;
      if (kind == K_G1) {
        A = (const u16*)(ws + OFF_H);
        of = (float*)(ws + OFF_MIX);
        if (s != 1) { Wt = (const u16*)(ws + OFF_WT_GU) + (size_t)(i * 2 + (s >> 1)) * 5632 * 1024; N = 5632; epi = EPI_SWIGLU; }
        else if (i == 0) { Wt = (const u16*)(ws + OFF_WT_AQKV); N = 1536; epi = EPI_ROPE; ldc = 1536; }
        else if (i == 2) { Wt = (const u16*)(ws + OFF_WT_NQKV); N = 3072; ldc = 3072; }
        else { Wt = (const u16*)(ws + OFF_WT_DIN); N = 3328; epi = EPI_SPLIT; of = (float*)(ws + OFF_MIX + MX_RAW); of2 = (float*)(ws + OFF_MIX + MX_ZB); }
      } else {
        A = (const u16*)(ws + OFF_ACT);
        if (s != 1) { Wt = (const u16*)(ws + OFF_WT_D) + (size_t)(i * 2 + (s >> 1)) * 1024 * 2816; lda = 2816; K = 2816; }
        else if (i == 0) Wt = (const u16*)(ws + OFF_WT_AO);
        else if (i == 1) { Wt = (const u16*)(ws + OFF_WT_GLU); N = 2048; epi = EPI_GLU; }
        else if (i == 2) Wt = (const u16*)(ws + OFF_WT_NO);
        else Wt = (const u16*)(ws + OFF_WT_DO);
      }
      gemm_phase(A, lda, Wt, K, N, epi, of, ldc, (u16*)(ws + OFF_ACT), of2, bid, nb, smem, tidx);
    } else if (kind == K_RN) {
      const int sub = arg;
      const int pi = sub > 0 ? (sub - 1) / 3 : -1, ps = sub > 0 ? (sub - 1) % 3 : 0;
      const int ni = sub < 12 ? sub / 3 : -1, ns = sub % 3;
      rn_phase(p, pi, ps, ni, ns, sub == 4, bid, nb, tidx);
    } else if (kind == K_PREP) prep_phase(p, bid, nb, smem, tidx);
    else if (kind == K_ATTN) attn_phase(p, arg, bid, nb, smem, tidx);
    else if (kind == K_S5A) s5_phase(p, 0, bid, nb, smem, tidx);
    else if (kind == K_S5B) s5_phase(p, 1, bid, nb, smem, tidx);
    else if (kind == K_S5C) s5c_phase(p, bid, nb, tidx);
    else if (kind == K_DNA) dna_phase(p, bid, nb, tidx);
    else if (kind == K_DNB) dnb_phase(p, bid, nb, smem, tidx);
    else if (kind == K_DNC) dnc_phase(p, bid, nb, smem, tidx);
    else dnd_phase(p, bid, nb, tidx);
    if (ph + 1 < phi) {
      if (pk.hi > 100000) grid.sync();
      xcd_barrier(xb);
    }
  }
}

extern "C" void kernel_launch(void* const* d_in, const int* in_sizes, int n_in, void* d_out, int out_size, void* d_ws, size_t ws_size,
                              hipStream_t stream) {
  static int grid_blocks = 0;
  if (!grid_blocks) {
    if (n_in != 38 || ws_size < WS_NEED) { fprintf(stderr, "kernel_launch: unexpected n_in %d or ws %zu < %zu\n", n_in, ws_size, (size_t)WS_NEED); grid_blocks = -1; return; }
    int dev = 0, cus = 0, per_cu = 0;
    hipGetDevice(&dev);
    hipDeviceGetAttribute(&cus, hipDeviceAttributeMultiprocessorCount, dev);
    hipFuncSetAttribute((const void*)mega, hipFuncAttributeMaxDynamicSharedMemorySize, SMEM);
    hipOccupancyMaxActiveBlocksPerMultiprocessor(&per_cu, mega, 256, SMEM);
    if (per_cu < 1) per_cu = 1;
    if (per_cu > 2) per_cu = 2;
    grid_blocks = cus * per_cu;
  }
  if (grid_blocks < 0) return;
  P p{};
  const float** pp = (const float**)&p;
  for (int i = 0; i < 38; ++i) pp[i] = (const float*)d_in[i];
  p.out = (float*)d_out;
  p.ws = (char*)d_ws;
  hipMemsetAsync((char*)d_ws + OFF_BAR, 0, 16384, stream);
#if MULTI_LAUNCH
  for (int ph = 0; ph < NPH; ++ph) {
    p.lo = ph; p.hi = ph + 1;
    hipLaunchKernelGGL(mega, dim3(grid_blocks), dim3(256), SMEM, stream, p);
  }
#else
  p.lo = 0; p.hi = NPH;
  void* args[] = {&p};
  hipError_t e = hipLaunchCooperativeKernel((void*)mega, dim3(grid_blocks), dim3(256), args, SMEM, stream);
  if (e != hipSuccess) fprintf(stderr, "cooperative launch failed: %s (grid %d)\n", hipGetErrorString(e), grid_blocks);
#endif
}
```

```cpp
#include <hip/hip_runtime.h>
#include <hip/hip_cooperative_groups.h>
#include <cstdio>
namespace cg = cooperative_groups;

#ifndef MULTI_LAUNCH
#define MULTI_LAUNCH 0
#endif

typedef unsigned short u16;
using bf16x8 = __attribute__((ext_vector_type(8))) short;
using f32x4 = __attribute__((ext_vector_type(4))) float;
#define DEVI __device__ __forceinline__

constexpr int T = 12288, TC = 4096, D = 1024, DFF = 2816;
constexpr int SMEM = 128 * 1024;
constexpr int NPH = 46;

constexpr size_t OFF_WT_GU = 0;
constexpr size_t OFF_WT_D = OFF_WT_GU + (size_t)8 * 5632 * 1024 * 2;
constexpr size_t OFF_WT_AQKV = OFF_WT_D + (size_t)8 * 1024 * 2816 * 2;
constexpr size_t OFF_WT_AO = OFF_WT_AQKV + (size_t)1536 * 1024 * 2;
constexpr size_t OFF_WT_GLU = OFF_WT_AO + (size_t)1024 * 1024 * 2;
constexpr size_t OFF_WT_NQKV = OFF_WT_GLU + (size_t)2048 * 1024 * 2;
constexpr size_t OFF_WT_NO = OFF_WT_NQKV + (size_t)3072 * 1024 * 2;
constexpr size_t OFF_WT_DIN = OFF_WT_NO + (size_t)1024 * 1024 * 2;
constexpr size_t OFF_WT_DO = OFF_WT_DIN + (size_t)3328 * 1024 * 2;
constexpr size_t OFF_MODS = OFF_WT_DO + (size_t)1024 * 1024 * 2;
constexpr size_t OFF_H = OFF_MODS + (size_t)4 * 3 * 9216 * 4;
constexpr size_t OFF_ACT = OFF_H + (size_t)T * 1024 * 2;
constexpr size_t OFF_Y = OFF_ACT + (size_t)T * 2816 * 2;
constexpr size_t OFF_MIX = OFF_Y + (size_t)T * 1024 * 4;
constexpr size_t MX_HF = 0;
constexpr size_t MX_YD = MX_HF + (size_t)T * 1024 * 4;
constexpr size_t MX_E = MX_YD + (size_t)2 * T * 1024 * 4;
constexpr size_t MX_RAW = 0;
constexpr size_t MX_ZB = MX_RAW + (size_t)T * 2048 * 4;
constexpr size_t MX_QC = MX_ZB + (size_t)T * 1280 * 4;
constexpr size_t MX_KC = MX_QC + (size_t)T * 512 * 4;
constexpr size_t MX_VC = MX_KC + (size_t)T * 512 * 4;
constexpr size_t MX_W = MX_VC + (size_t)T * 1024 * 4;
constexpr size_t MX_BETA = MX_W + (size_t)3072 * 64 * 128 * 4;
constexpr size_t MX_G = MX_BETA + (size_t)2 * T * 8 * 4;
constexpr size_t MX_O1 = MX_G + (size_t)2 * T * 8 * 4;
constexpr size_t MX_END = MX_O1 + (size_t)T * 1024 * 4;
constexpr size_t AX_AQK = 0;
constexpr size_t AX_GC = AX_AQK + (size_t)3072 * 64 * 64 * 4;
constexpr size_t OFF_BAR = OFF_MIX + MX_END;
constexpr size_t WS_NEED = OFF_BAR + 16384;

constexpr size_t OUT_AK = (size_t)T * 1024;
constexpr size_t OUT_AV = OUT_AK + 1048576;
constexpr size_t OUT_SRE = OUT_AV + 1048576;
constexpr size_t OUT_SIM = OUT_SRE + 131072;
constexpr size_t OUT_NK = OUT_SIM + 131072;
constexpr size_t OUT_NV = OUT_NK + 4194304;
constexpr size_t OUT_DN = OUT_NV + 4194304;

struct P {
  const float *x_prompt, *x_sample, *cache_ak, *cache_av, *s5_sre, *s5_sim, *cache_nk, *cache_nv, *state_dn, *c, *c_ctx;
  const float *norm_g, *w_ada, *b_ada, *w_gu, *w_d, *a_wqkv, *a_wo, *a_sink;
  const float *lam_re, *lam_im, *log_dt, *b_re, *b_im, *c_re, *c_im, *s5_d, *s5_wglu;
  const float *na_wqkv, *na_wo, *na_rpb, *dn_win, *dn_conv, *dn_wba, *dn_alog, *dn_dtb, *dn_outg, *dn_wo;
  float* out;
  char* ws;
  int lo, hi;
};

typedef __attribute__((ext_vector_type(2))) __bf16 bf16x2_t;
typedef __attribute__((ext_vector_type(2))) float f32x2_t;
DEVI unsigned pk2bf(float lo, float hi) {
  bf16x2_t r = __builtin_convertvector((f32x2_t){lo, hi}, bf16x2_t);
  return __builtin_bit_cast(unsigned, r);
}
DEVI u16 f2bf(float f) { return (u16)pk2bf(f, f); }
template <typename Tp>
DEVI Tp* uni(Tp* ptr) {
  unsigned long long v = (unsigned long long)ptr;
  unsigned lo = __builtin_amdgcn_readfirstlane((unsigned)v), hi = __builtin_amdgcn_readfirstlane((unsigned)(v >> 32));
  return (Tp*)(((unsigned long long)hi << 32) | lo);
}
DEVI float dpp_ror(float v, const int ctrl) { return v; }
#define ROW_ROR(v, n) __builtin_bit_cast(float, __builtin_amdgcn_update_dpp(0, __builtin_bit_cast(int, (v)), 0x120 + (n), 0xf, 0xf, false))
DEVI float rowmax16(float v) {
  v = fmaxf(v, ROW_ROR(v, 8)); v = fmaxf(v, ROW_ROR(v, 4)); v = fmaxf(v, ROW_ROR(v, 2)); v = fmaxf(v, ROW_ROR(v, 1));
  return v;
}
DEVI float rowsum16(float v) {
  v += ROW_ROR(v, 8); v += ROW_ROR(v, 4); v += ROW_ROR(v, 2); v += ROW_ROR(v, 1);
  return v;
}
typedef __attribute__((ext_vector_type(4))) float nt_f4;
DEVI float4 ld_nt(const float4* p) { nt_f4 v = __builtin_nontemporal_load((const nt_f4*)p); return make_float4(v.x, v.y, v.z, v.w); }
DEVI float wsum(float v) {
  v = rowsum16(v);
  v += __shfl_xor(v, 16); v += __shfl_xor(v, 32);
  return v;
}
DEVI float sigmoidf_(float v) { return 1.f / (1.f + expf(-v)); }
DEVI bf16x8 pack8(const float* v) {
  typedef __attribute__((ext_vector_type(4))) unsigned u32x4_t;
  u32x4_t r = {pk2bf(v[0], v[1]), pk2bf(v[2], v[3]), pk2bf(v[4], v[5]), pk2bf(v[6], v[7])};
  return __builtin_bit_cast(bf16x8, r);
}

DEVI void tjob(const P& p, int t, const float*& src, u16*& dst, int& K, int& N, int& F, int& id) {
  if (t < 11264) { int m = t / 1408; id = t % 1408; src = p.w_gu + (size_t)m * 1024 * 5632; dst = (u16*)(p.ws + OFF_WT_GU) + (size_t)m * 5632 * 1024; K = 1024; N = 5632; F = 2816; return; }
  t -= 11264;
  if (t < 5632) { int m = t / 704; id = t % 704; src = p.w_d + (size_t)m * 2816 * 1024; dst = (u16*)(p.ws + OFF_WT_D) + (size_t)m * 1024 * 2816; K = 2816; N = 1024; F = 0; return; }
  t -= 5632;
  K = 1024; F = 0;
  if (t < 384) { id = t; src = p.a_wqkv; dst = (u16*)(p.ws + OFF_WT_AQKV); N = 1536; return; }
  t -= 384;
  if (t < 256) { id = t; src = p.a_wo; dst = (u16*)(p.ws + OFF_WT_AO); N = 1024; return; }
  t -= 256;
  if (t < 512) { id = t; src = p.s5_wglu; dst = (u16*)(p.ws + OFF_WT_GLU); N = 2048; F = 1024; return; }
  t -= 512;
  if (t < 768) { id = t; src = p.na_wqkv; dst = (u16*)(p.ws + OFF_WT_NQKV); N = 3072; return; }
  t -= 768;
  if (t < 256) { id = t; src = p.na_wo; dst = (u16*)(p.ws + OFF_WT_NO); N = 1024; return; }
  t -= 256;
  if (t < 768) { id = t; src = p.dn_win; dst = (u16*)(p.ws + OFF_WT_DIN); N = 3072; return; }
  t -= 768;
  id = t; src = p.dn_wo; dst = (u16*)(p.ws + OFF_WT_DO); N = 1024;
}
constexpr int NTJ = 11264 + 5632 + 384 + 256 + 512 + 768 + 256 + 768 + 256;

DEVI void prep_phase(const P& p, int bid, int nb, char* smem, const int tidx) {
  const int tid = tidx;
  {
    const float4* s0 = (const float4*)p.x_prompt;
    const float4* s1 = (const float4*)p.x_sample;
    float4* dst = (float4*)p.out;
    const int n0 = TC * D / 4, n = T * D / 4;
    for (int i = bid * 256 + tid; i < n; i += nb * 256) dst[i] = i < n0 ? s0[i] : s1[i - n0];
  }
  {
    u16* dst = (u16*)(p.ws + OFF_WT_DIN) + (size_t)3072 * 1024;
    for (int i = bid * 256 + tid; i < 256 * 1024; i += nb * 256) {
      int r = i >> 10, k = i & 1023;
      float v = r < 32 ? p.dn_wba[((size_t)(r >> 4) * 1024 + k) * 16 + (r & 15)] : 0.f;
      dst[i] = f2bf(v);
    }
  }
  {
    float* sc = (float*)smem;
    float* red = sc + 3072;
    bool staged = false;
    float* mods = (float*)(p.ws + OFF_MODS);
    for (int it = bid; it < 576; it += nb) {
      if (!staged) {
        for (int k = tid; k < 3072; k += 256) { float v = k < 1024 ? p.c_ctx[k] : p.c[k - 1024]; sc[k] = v / (1.f + expf(-v)); }
        __syncthreads();
        staged = true;
      }
      int i = it / 144, cgp = it % 144;
      int cl = tid & 63, kq = tid >> 6;
      int col = cgp * 64 + cl;
      const float* w = p.w_ada + ((size_t)i * 1024 + kq * 256) * 9216 + col;
      float a0 = 0, a1 = 0, a2 = 0;
#pragma unroll 32
      for (int k = 0; k < 256; ++k) {
        float wv = __builtin_nontemporal_load(w + (size_t)k * 9216);
        int kk = kq * 256 + k;
        a0 += sc[kk] * wv; a1 += sc[1024 + kk] * wv; a2 += sc[2048 + kk] * wv;
      }
      red[(0 * 4 + kq) * 64 + cl] = a0; red[(1 * 4 + kq) * 64 + cl] = a1; red[(2 * 4 + kq) * 64 + cl] = a2;
      __syncthreads();
      if (tid < 192) {
        int c = tid >> 6;
        float s = red[(c * 4 + 0) * 64 + cl] + red[(c * 4 + 1) * 64 + cl] + red[(c * 4 + 2) * 64 + cl] + red[(c * 4 + 3) * 64 + cl];
        mods[((size_t)i * 3 + c) * 9216 + col] = s + p.b_ada[(size_t)i * 9216 + col];
      }
      __syncthreads();
    }
    __syncthreads();
  }
  {
    float* tl = (float*)smem;
    for (int t0 = bid * 4; t0 < NTJ; t0 += nb * 4) {
      float4 v[4][4];
      u16* dsts[4]; int Ks_[4], rows[4], k0s[4];
#pragma unroll
      for (int u = 0; u < 4; ++u) {
        const float* src; u16* dst; int K, N, F, id;
        tjob(p, t0 + u, src, dst, K, N, F, id);
        int ntn = N >> 6;
        int kt = id / ntn, ntl = id % ntn;
        int k0 = kt * 64, n0 = ntl * 64;
#pragma unroll
        for (int r = 0; r < 4; ++r) {
          int kk = (tid >> 4) + 16 * r, nn = (tid & 15) * 4;
          v[u][r] = ld_nt((const float4*)(src + (size_t)(k0 + kk) * N + n0 + nn));
        }
        int n = n0 + (tid >> 2), row = n;
        if (F) { int which = n >= F; int j = n - which * F; row = (j >> 4) * 32 + which * 16 + (j & 15); }
        dsts[u] = dst; Ks_[u] = K; rows[u] = row; k0s[u] = k0;
      }
      __syncthreads();
#pragma unroll
      for (int u = 0; u < 4; ++u)
#pragma unroll
        for (int r = 0; r < 4; ++r) {
          int kk = (tid >> 4) + 16 * r, nn = (tid & 15) * 4;
          float* t = tl + u * 64 * 65 + kk * 65 + nn;
          t[0] = v[u][r].x; t[1] = v[u][r].y; t[2] = v[u][r].z; t[3] = v[u][r].w;
        }
      __syncthreads();
#pragma unroll
      for (int u = 0; u < 4; ++u) {
        int nn = tid >> 2, q = tid & 3;
        u16 o[16];
#pragma unroll
        for (int i = 0; i < 16; ++i) o[i] = f2bf(tl[u * 64 * 65 + (q * 16 + i) * 65 + nn]);
        uint4 v0, v1;
        v0.x = o[0] | ((unsigned)o[1] << 16); v0.y = o[2] | ((unsigned)o[3] << 16); v0.z = o[4] | ((unsigned)o[5] << 16); v0.w = o[6] | ((unsigned)o[7] << 16);
        v1.x = o[8] | ((unsigned)o[9] << 16); v1.y = o[10] | ((unsigned)o[11] << 16); v1.z = o[12] | ((unsigned)o[13] << 16); v1.w = o[14] | ((unsigned)o[15] << 16);
        uint4* d4 = (uint4*)(dsts[u] + (size_t)rows[u] * Ks_[u] + k0s[u] + q * 16);
        d4[0] = v0; d4[1] = v1;
      }
    }
  }
}

DEVI void rn_phase(const P& p, int pi, int ps, int ni, int ns, bool hf, int bid, int nb, const int tidx) {
  const int wave = tidx >> 6, lane = tidx & 63;
  float* X = p.out;
  const float* Y = (const float*)(p.ws + OFF_Y);
  const float* mods = (const float*)(p.ws + OFF_MODS);
  u16* H = (u16*)(p.ws + OFF_H);
  float* HF = (float*)(p.ws + OFF_MIX + MX_HF);
  constexpr int NT = 4;
  for (int t0 = (bid * 4 + wave) * NT; t0 < T; t0 += nb * 4 * NT) {
    const int cnd = t0 < TC ? 0 : 1 + ((t0 - TC) >> 12);
    float4 x[NT][4];
#pragma unroll
    for (int u = 0; u < NT; ++u)
#pragma unroll
      for (int r = 0; r < 4; ++r) x[u][r] = *(const float4*)(X + (size_t)(t0 + u) * 1024 + r * 256 + lane * 4);
    if (pi >= 0) {
      float4 y[NT][4];
      float ss[NT];
#pragma unroll
      for (int u = 0; u < NT; ++u) {
        ss[u] = 0.f;
#pragma unroll
        for (int r = 0; r < 4; ++r) {
          const uint2 yb = *(const uint2*)((const u16*)Y + (size_t)(t0 + u) * 1024 + r * 256 + lane * 4);
          y[u][r] = make_float4(__uint_as_float(yb.x << 16), __uint_as_float(yb.x & 0xffff0000u), __uint_as_float(yb.y << 16), __uint_as_float(yb.y & 0xffff0000u));
          ss[u] += y[u][r].x * y[u][r].x + y[u][r].y * y[u][r].y + y[u][r].z * y[u][r].z + y[u][r].w * y[u][r].w;
        }
      }
#pragma unroll
      for (int o = 32; o; o >>= 1)
#pragma unroll
        for (int u = 0; u < NT; ++u) ss[u] += __shfl_xor(ss[u], o);
      const float* g = p.norm_g + (size_t)(pi * 6 + 2 * ps + 1) * 1024;
      const float* gate = mods + ((size_t)(pi * 3 + cnd) * 9 + 3 * ps + 2) * 1024;
      const float wgt = ps == 1 ? 1.f : 0.5f;
#pragma unroll
      for (int r = 0; r < 4; ++r) {
        const int e = r * 256 + lane * 4;
        float4 gg = *(const float4*)(g + e), ga = *(const float4*)(gate + e);
        gg.x *= wgt * ga.x; gg.y *= wgt * ga.y; gg.z *= wgt * ga.z; gg.w *= wgt * ga.w;
#pragma unroll
        for (int u = 0; u < NT; ++u) {
          const float rinv = rsqrtf(ss[u] * (1.f / 1024.f) + 1e-6f);
          x[u][r].x += gg.x * (y[u][r].x * rinv);
          x[u][r].y += gg.y * (y[u][r].y * rinv);
          x[u][r].z += gg.z * (y[u][r].z * rinv);
          x[u][r].w += gg.w * (y[u][r].w * rinv);
          *(float4*)(X + (size_t)(t0 + u) * 1024 + e) = x[u][r];
        }
      }
    }
    if (ni >= 0) {
      float ss[NT];
#pragma unroll
      for (int u = 0; u < NT; ++u) {
        ss[u] = 0.f;
#pragma unroll
        for (int r = 0; r < 4; ++r) ss[u] += x[u][r].x * x[u][r].x + x[u][r].y * x[u][r].y + x[u][r].z * x[u][r].z + x[u][r].w * x[u][r].w;
      }
#pragma unroll
      for (int o = 32; o; o >>= 1)
#pragma unroll
        for (int u = 0; u < NT; ++u) ss[u] += __shfl_xor(ss[u], o);
      const float* g = p.norm_g + (size_t)(ni * 6 + 2 * ns) * 1024;
      const float* sh = mods + ((size_t)(ni * 3 + cnd) * 9 + 3 * ns) * 1024;
      const float* scl = sh + 1024;
#pragma unroll
      for (int r = 0; r < 4; ++r) {
        const int e = r * 256 + lane * 4;
        float4 gg = *(const float4*)(g + e), s4 = *(const float4*)(sh + e), c4 = *(const float4*)(scl + e);
        gg.x *= 1.f + c4.x; gg.y *= 1.f + c4.y; gg.z *= 1.f + c4.z; gg.w *= 1.f + c4.w;
#pragma unroll
        for (int u = 0; u < NT; ++u) {
          const float rinv = rsqrtf(ss[u] * (1.f / 1024.f) + 1e-6f);
          float4 h;
          h.x = x[u][r].x * rinv * gg.x + s4.x;
          h.y = x[u][r].y * rinv * gg.y + s4.y;
          h.z = x[u][r].z * rinv * gg.z + s4.z;
          h.w = x[u][r].w * rinv * gg.w + s4.w;
          uint2 hb;
          hb.x = f2bf(h.x) | ((unsigned)f2bf(h.y) << 16);
          hb.y = f2bf(h.z) | ((unsigned)f2bf(h.w) << 16);
          *(uint2*)(H + (size_t)(t0 + u) * 1024 + e) = hb;
          if (hf) *(float4*)(HF + (size_t)(t0 + u) * 1024 + e) = h;
        }
      }
    }
  }
}

enum { EPI_F32 = 0, EPI_SWIGLU = 1, EPI_GLU = 2, EPI_ROPE = 3, EPI_SPLIT = 4, EPI_YBF = 5 };
constexpr int GBUF = 28672;

DEVI void gemm_phase(const u16* A, int lda, const u16* Bt, int K, int N, int epi,
                     float* of, int ldc, u16* oh, float* of2, int bid, int nb, char* smem, const int tidx) {
  const int tid = tidx, wid = tid >> 6, lane = tid & 63, wr = wid >> 1, wc = wid & 1, fr = lane & 15, fq = lane >> 4;
  lda = __builtin_amdgcn_readfirstlane(lda); K = __builtin_amdgcn_readfirstlane(K); N = __builtin_amdgcn_readfirstlane(N);
  epi = __builtin_amdgcn_readfirstlane(epi); ldc = __builtin_amdgcn_readfirstlane(ldc);
  const int ntn = N >> 8, ntiles = 64 * ntn, nk = K >> 5;
  const int s_row = tid >> 2, s_k = ((tid & 3) ^ ((0x78 >> (2 * ((tid >> 4) & 3))) & 3)) * 8;
  const int r_swz = (fq ^ ((0x78 >> (2 * ((fr >> 2) & 3))) & 3)) * 16;
  const int a_off = (wr * 96 + fr) * 64 + r_swz;
  const int b_off = 12288 + (wc * 128 + fr) * 64 + r_swz;
  uint4 r00, r01, r02, r03, r04, r05, r06, r10, r11, r12, r13, r14, r15, r16;
  uint4 r20, r21, r22, r23, r24, r25, r26, r30, r31, r32, r33, r34, r35, r36;
  const u16 *Ag, *Bg;
  unsigned ao0, ao1, ao2, bo0, bo1, bo2, bo3;
#define TILE_SETUP(tl)                                                                                    \
  do {                                                                                                    \
    const int br_ = ((tl) & 63) * 192, bc_ = ((tl) >> 6) * 256;                                           \
    Ag = A + (size_t)(br_ + s_row) * lda + s_k;                                                           \
    Bg = Bt + (size_t)(bc_ + s_row) * K + s_k;                                                            \
    ao0 = (unsigned)(((br_ + s_row) * lda + s_k) * 2); ao1 = ao0 + (unsigned)(128 * lda); ao2 = ao0 + (unsigned)(256 * lda);   \
    bo0 = (unsigned)(((bc_ + s_row) * K + s_k) * 2); bo1 = bo0 + (unsigned)(128 * K); bo2 = bo0 + (unsigned)(256 * K); bo3 = bo0 + (unsigned)(384 * K); \
  } while (0)
#define GLOAD(r, kt)                                                                                      \
  do {                                                                                                    \
    r##0 = *(const uint4*)(Ag + (kt) * 32);                                                               \
    r##1 = *(const uint4*)(Ag + (size_t)64 * lda + (kt) * 32);                                            \
    r##2 = *(const uint4*)(Ag + (size_t)128 * lda + (kt) * 32);                                           \
    r##3 = *(const uint4*)(Bg + (kt) * 32);                                                               \
    r##4 = *(const uint4*)(Bg + (size_t)64 * K + (kt) * 32);                                              \
    r##5 = *(const uint4*)(Bg + (size_t)128 * K + (kt) * 32);                                             \
    r##6 = *(const uint4*)(Bg + (size_t)192 * K + (kt) * 32);                                             \
  } while (0)
  if (bid < ntiles) { TILE_SETUP(bid); GLOAD(r0, 0); GLOAD(r1, 1); GLOAD(r2, 2); GLOAD(r3, 3); }
  for (int tile = bid; tile < ntiles; tile += nb) {
    const int tn = tile >> 6, tm = tile & 63;
    const int brow = tm * 192, bcol = tn * 256;
    f32x4 acc[6][8];
#pragma unroll
    for (int m = 0; m < 6; ++m)
#pragma unroll
      for (int n = 0; n < 8; ++n) acc[m][n] = f32x4{0.f, 0.f, 0.f, 0.f};
#define LDFRAG(buf, fa, fb)                                                                               \
  do {                                                                                                    \
    const char* sb_ = smem + (buf) * GBUF;                                                                \
    _Pragma("unroll") for (int n_ = 0; n_ < 8; ++n_) fb[n_] = *(const bf16x8*)(sb_ + b_off + n_ * 1024);  \
    _Pragma("unroll") for (int m_ = 0; m_ < 6; ++m_) fa[m_] = *(const bf16x8*)(sb_ + a_off + m_ * 1024);  \
  } while (0)
#define SWRITE(r, buf)                                                                                    \
  do {                                                                                                    \
    char* sb_ = smem + (buf) * GBUF + tid * 16;                                                           \
    *(uint4*)(sb_) = r##0; *(uint4*)(sb_ + 4096) = r##1; *(uint4*)(sb_ + 8192) = r##2;                    \
    *(uint4*)(sb_ + 12288) = r##3; *(uint4*)(sb_ + 16384) = r##4; *(uint4*)(sb_ + 20480) = r##5; *(uint4*)(sb_ + 24576) = r##6; \
  } while (0)
#define LBAR() do { asm volatile("s_waitcnt lgkmcnt(0)" ::: "memory"); __builtin_amdgcn_s_barrier(); asm volatile("" ::: "memory"); } while (0)
#define SB() __builtin_amdgcn_sched_barrier(0)
#define MF(m, n, fa, fb) asm volatile("v_mfma_f32_16x16x32_bf16 %0, %1, %2, %0" : "+a"(acc[m][n]) : "v"(fa[m]), "v"(fb[n]))
#define STEP(ca, cb, na, nb_, rb, rl, kl, rw, wb)  \
  do {  \
    const char* sr_ = smem + (rb) * GBUF;  \
    char* sw_ = smem + (wb) * GBUF + tid * 16;  \
    const char* ab_ = (const char*)A + (size_t)(kl) * 64;  \
    const char* bb_ = (const char*)Bt + (size_t)(kl) * 64;  \
    nb_[0] = *(const bf16x8*)(sr_ + b_off + 0); SB();  \
    MF(0, 0, ca, cb); MF(0, 1, ca, cb); SB();  \
    nb_[1] = *(const bf16x8*)(sr_ + b_off + 1024); SB();  \
    MF(0, 2, ca, cb); MF(0, 3, ca, cb); SB();  \
    rl##0 = *(const uint4*)(ab_ + ao0); SB();  \
    MF(0, 4, ca, cb); MF(0, 5, ca, cb); SB();  \
    nb_[2] = *(const bf16x8*)(sr_ + b_off + 2048); SB();  \
    MF(0, 6, ca, cb); MF(0, 7, ca, cb); SB();  \
    *(uint4*)(sw_ + 0) = rw##0; SB();  \
    MF(1, 0, ca, cb); MF(1, 1, ca, cb); SB();  \
    nb_[3] = *(const bf16x8*)(sr_ + b_off + 3072); SB();  \
    MF(1, 2, ca, cb); MF(1, 3, ca, cb); SB();  \
    rl##1 = *(const uint4*)(ab_ + ao1); SB();  \
    MF(1, 4, ca, cb); MF(1, 5, ca, cb); SB();  \
    nb_[4] = *(const bf16x8*)(sr_ + b_off + 4096); SB();  \
    MF(1, 6, ca, cb); MF(1, 7, ca, cb); SB();  \
    *(uint4*)(sw_ + 4096) = rw##1; SB();  \
    MF(2, 0, ca, cb); MF(2, 1, ca, cb); SB();  \
    nb_[5] = *(const bf16x8*)(sr_ + b_off + 5120); SB();  \
    MF(2, 2, ca, cb); MF(2, 3, ca, cb); SB();  \
    rl##2 = *(const uint4*)(ab_ + ao2); SB();  \
    MF(2, 4, ca, cb); MF(2, 5, ca, cb); SB();  \
    nb_[6] = *(const bf16x8*)(sr_ + b_off + 6144); SB();  \
    MF(2, 6, ca, cb); MF(2, 7, ca, cb); SB();  \
    *(uint4*)(sw_ + 8192) = rw##2; SB();  \
    MF(3, 0, ca, cb); MF(3, 1, ca, cb); SB();  \
    nb_[7] = *(const bf16x8*)(sr_ + b_off + 7168); SB();  \
    MF(3, 2, ca, cb); MF(3, 3, ca, cb); SB();  \
    rl##3 = *(const uint4*)(bb_ + bo0); SB();  \
    MF(3, 4, ca, cb); MF(3, 5, ca, cb); SB();  \
    na[0] = *(const bf16x8*)(sr_ + a_off + 0); SB();  \
    MF(3, 6, ca, cb); MF(3, 7, ca, cb); SB();  \
    *(uint4*)(sw_ + 12288) = rw##3; SB();  \
    MF(4, 0, ca, cb); MF(4, 1, ca, cb); SB();  \
    na[1] = *(const bf16x8*)(sr_ + a_off + 1024); SB();  \
    MF(4, 2, ca, cb); MF(4, 3, ca, cb); SB();  \
    rl##4 = *(const uint4*)(bb_ + bo1); SB();  \
    MF(4, 4, ca, cb); MF(4, 5, ca, cb); SB();  \
    na[2] = *(const bf16x8*)(sr_ + a_off + 2048); SB();  \
    MF(4, 6, ca, cb); MF(4, 7, ca, cb); SB();  \
    *(uint4*)(sw_ + 16384) = rw##4; na[3] = *(const bf16x8*)(sr_ + a_off + 3072); SB();  \
    MF(5, 0, ca, cb); MF(5, 1, ca, cb); SB();  \
    rl##5 = *(const uint4*)(bb_ + bo2); na[4] = *(const bf16x8*)(sr_ + a_off + 4096); SB();  \
    MF(5, 2, ca, cb); MF(5, 3, ca, cb); SB();  \
    *(uint4*)(sw_ + 20480) = rw##5; na[5] = *(const bf16x8*)(sr_ + a_off + 5120); SB();  \
    MF(5, 4, ca, cb); MF(5, 5, ca, cb); SB();  \
    rl##6 = *(const uint4*)(bb_ + bo3); *(uint4*)(sw_ + 24576) = rw##6; SB();  \
    MF(5, 6, ca, cb); MF(5, 7, ca, cb); SB();  \
  } while (0)
    bf16x8 a0[6], b0[8], a1[6], b1[8];
    LBAR();
    SWRITE(r0, 0);
    SWRITE(r1, 1);
    LBAR();
    LDFRAG(0, a0, b0);
#define KCL(x) ((x) < nk ? (x) : nk - 1)
    for (int kt = 0; kt < nk; kt += 4) {
      STEP(a0, b0, a1, b1, 1, r0, KCL(kt + 4), r2, 0);
      LBAR();
      STEP(a1, b1, a0, b0, 0, r1, KCL(kt + 5), r3, 1);
      LBAR();
      STEP(a0, b0, a1, b1, 1, r2, KCL(kt + 6), r0, 0);
      LBAR();
      STEP(a1, b1, a0, b0, 0, r3, KCL(kt + 7), r1, 1);
      LBAR();
    }
#undef KCL
    if (tile + nb < ntiles) { TILE_SETUP(tile + nb); GLOAD(r0, 0); GLOAD(r1, 1); GLOAD(r2, 2); GLOAD(r3, 3); }
#undef LDFRAG
#undef SWRITE
#undef STEP
#undef MF
    asm volatile("s_nop 15");
    asm volatile("s_nop 15");
    {
      float* ep = (float*)smem + wid * (32 * 132);
      const int col0 = bcol + wc * 128;
      float* dst = of; int ld = ldc; int cb = col0;
      if (epi == EPI_SPLIT) { if (bcol < 2048) { ld = 2048; } else { dst = of2; ld = 1280; cb = col0 - 2048; } }
      const float inv = exp2f(-(float)(lane & 15) * (13.287712379549449f / 16.f));
      auto epi_pass = [&](const f32x4 (&ac0)[8], const f32x4 (&ac1)[8], const int q) __attribute__((always_inline)) {
#pragma unroll
        for (int n = 0; n < 8; ++n)
#pragma unroll
          for (int j = 0; j < 4; ++j) {
            ep[(fq * 4 + j) * 132 + n * 16 + fr] = ac0[n][j];
            ep[(16 + fq * 4 + j) * 132 + n * 16 + fr] = ac1[n][j];
          }
        asm volatile("s_waitcnt lgkmcnt(0)" ::: "memory");
        const int grow0 = brow + wr * 96 + q * 32;
        if (epi == EPI_F32 || epi == EPI_SPLIT) {
#pragma unroll 4
          for (int r = 0; r < 32; ++r) {
            float2 v = *(const float2*)(ep + r * 132 + lane * 2);
            __builtin_nontemporal_store(v.x, dst + (size_t)(grow0 + r) * ld + cb + lane * 2); __builtin_nontemporal_store(v.y, dst + (size_t)(grow0 + r) * ld + cb + lane * 2 + 1);
          }
        } else if (epi == EPI_YBF) {
          u16* yb = (u16*)of;
#pragma unroll 4
          for (int r = 0; r < 32; ++r) {
            float2 v = *(const float2*)(ep + r * 132 + lane * 2);
            __builtin_nontemporal_store(pk2bf(v.x, v.y), (unsigned*)(yb + (size_t)(grow0 + r) * 1024 + col0 + lane * 2));
          }
        } else if (epi == EPI_SWIGLU) {
          const int oc = (lane & 31) * 2, ci = (oc >> 4) * 32 + (oc & 15), rh = lane >> 5;
#pragma unroll 4
          for (int r = 0; r < 32; r += 2) {
            const float2 g = *(const float2*)(ep + (r + rh) * 132 + ci), u = *(const float2*)(ep + (r + rh) * 132 + ci + 16);
            const float o0 = g.x * __builtin_amdgcn_rcpf(1.f + __expf(-g.x)) * u.x;
            const float o1 = g.y * __builtin_amdgcn_rcpf(1.f + __expf(-g.y)) * u.y;
            __builtin_nontemporal_store(pk2bf(o0, o1), (unsigned*)(oh + (size_t)(grow0 + r + rh) * DFF + (col0 >> 1) + oc));
          }
        } else if (epi == EPI_GLU) {
          const int oc = (lane & 31) * 2, ci = (oc >> 4) * 32 + (oc & 15), rh = lane >> 5;
#pragma unroll 4
          for (int r = 0; r < 32; r += 2) {
            const float2 a_ = *(const float2*)(ep + (r + rh) * 132 + ci), gt = *(const float2*)(ep + (r + rh) * 132 + ci + 16);
            const float o0 = a_.x * __builtin_amdgcn_rcpf(1.f + __expf(-gt.x));
            const float o1 = a_.y * __builtin_amdgcn_rcpf(1.f + __expf(-gt.y));
            __builtin_nontemporal_store(pk2bf(o0, o1), (unsigned*)((u16*)of + (size_t)(grow0 + r + rh) * 1024 + (col0 >> 1) + oc));
          }
        } else {
          const int hh = lane >> 5, sub = (lane >> 4) & 1, f = lane & 15;
          const int c0 = col0 + hh * 64;
          for (int r = 0; r < 32; ++r) {
            float x1 = ep[r * 132 + hh * 64 + sub * 32 + f], x2 = ep[r * 132 + hh * 64 + sub * 32 + 16 + f];
            const int row = grow0 + r;
            if (row >= TC && c0 < 1280) {
              int pos = (row - TC) & 4095;
              float ang = (float)(sub ? (pos & 63) : (pos >> 6)) * inv;
              float sn = __sinf(ang), cs = __cosf(ang);
              float n1 = x1 * cs - x2 * sn, n2 = x2 * cs + x1 * sn;
              x1 = n1; x2 = n2;
            }
            float* o = of + (size_t)row * 1536 + c0 + sub * 32 + f;
            o[0] = x1; o[16] = x2;
          }
        }
        asm volatile("s_waitcnt lgkmcnt(0)" ::: "memory");
      };
      epi_pass(acc[0], acc[1], 0);
      epi_pass(acc[2], acc[3], 1);
      epi_pass(acc[4], acc[5], 2);
    }
  }
#undef GLOAD
#undef TILE_SETUP
}

DEVI void attn_phase(const P& p, int kind, int bid, int nb, char* smem, const int tidx) {
  const int tid = tidx, wid = tid >> 6, lane = tid & 63, fr = lane & 15, fq = lane >> 4;
  const float* QKV = (const float*)(p.ws + OFF_MIX);
  const int ld = kind == 0 ? 1536 : 3072;
  u16* ACT = (u16*)(p.ws + OFF_ACT);
  {
    if (kind == 0) {
      float* ok = p.out + OUT_AK;
      float* ov = p.out + OUT_AV;
      for (int i = bid * 256 + tid; i < TC * 128; i += nb * 256) {
        int tok = i >> 7, c4 = (i & 127) * 4;
        float4 v = *(const float4*)(QKV + (size_t)tok * 1536 + 1024 + c4);
        if (c4 < 256) *(float4*)(ok + (size_t)tok * 256 + c4) = v; else *(float4*)(ov + (size_t)tok * 256 + c4 - 256) = v;
      }
    } else {
      float* ok = p.out + OUT_NK;
      float* ov = p.out + OUT_NV;
      for (int i = bid * 256 + tid; i < TC * 512; i += nb * 256) {
        int tok = i >> 9, c4 = (i & 511) * 4;
        float4 v = *(const float4*)(QKV + (size_t)tok * 3072 + 1024 + c4);
        if (c4 < 1024) *(float4*)(ok + (size_t)tok * 1024 + c4) = v; else *(float4*)(ov + (size_t)tok * 1024 + c4 - 1024) = v;
      }
    }
  }
  u16* Ks = (u16*)smem;
  u16* Vt = Ks + 2 * 64 * 72;
  u16* Ps = Vt + 2 * 64 * 72;
  u16* Pw = Ps + wid * 32 * 72;
  for (int it = bid; it < 1536; it += nb) {
    const bool lat = it < 1024;
    int b, h, qt;
    if ((nb & 7) == 0) {
      const int x = it & 7;
      if (lat) { const int j = it >> 3; h = 2 * x + (j & 1); b = (j >> 1) & 1; qt = j >> 2; }
      else { const int j = (it - 1024) >> 3; h = 2 * x + (j & 1); qt = (j >> 1) & 1; b = j >> 2; }
    } else if (lat) { b = it >> 9; h = (it >> 5) & 15; qt = it & 31; }
    else { int j = it - 1024; b = j >> 5; h = (j >> 1) & 15; qt = j & 1; }
    const int seqbase = lat ? TC + b * 4096 : b * 256;
    const int q0 = qt * 128;
    int kcol, vcol, cstride;
    const float *cK, *cV;
    if (kind == 0) {
      int kvh = h >> 2;
      kcol = 1024 + kvh * 64; vcol = 1280 + kvh * 64; cstride = 256;
      cK = p.cache_ak + ((size_t)b * 512 * 4 + kvh) * 64; cV = p.cache_av + ((size_t)b * 512 * 4 + kvh) * 64;
    } else {
      kcol = 1024 + h * 64; vcol = 2048 + h * 64; cstride = 1024;
      cK = p.cache_nk + ((size_t)b * 512 * 16 + h) * 64; cV = p.cache_nv + ((size_t)b * 512 * 16 + h) * 64;
    }
    int nloc, lo = 0, rs0 = 0;
    const int rq = 2 * qt + (wid >> 1);
    int rsq = rq - 4; rsq = rsq < 0 ? 0 : (rsq > 56 ? 56 : rsq);
    if (!lat) { nloc = 4; lo = 0; }
    else if (kind == 0) { lo = q0 - 128 < 0 ? 0 : q0 - 128; int hi = q0 + 256 > 4096 ? 4096 : q0 + 256; nloc = (hi - lo) >> 6; }
    else {
      rs0 = 2 * qt - 4; rs0 = rs0 < 0 ? 0 : (rs0 > 56 ? 56 : rs0);
      int rs1 = 2 * qt - 3; rs1 = rs1 < 0 ? 0 : (rs1 > 56 ? 56 : rs1);
      nloc = rs1 + 8 - rs0; lo = rs0 * 64;
    }
    const int ntile = nloc + (lat ? 8 : 0);
    bf16x8 qf[2][2];
#pragma unroll
    for (int mi = 0; mi < 2; ++mi) {
      const float* qp = QKV + (size_t)(seqbase + q0 + wid * 32 + mi * 16 + fr) * ld + h * 64 + fq * 8;
#pragma unroll
      for (int ks = 0; ks < 2; ++ks) {
        float4 a0 = *(const float4*)(qp + ks * 32), a1 = *(const float4*)(qp + ks * 32 + 4);
        const float qs = 0.125f * 1.4426950408889634f;
        float v[8] = {a0.x * qs, a0.y * qs, a0.z * qs, a0.w * qs, a1.x * qs, a1.y * qs, a1.z * qs, a1.w * qs};
        qf[mi][ks] = pack8(v);
      }
    }
    f32x4 o[2][4];
    float mrow[2][4], lrow[2][4];
#pragma unroll
    for (int mi = 0; mi < 2; ++mi)
#pragma unroll
      for (int n = 0; n < 4; ++n) { o[mi][n] = f32x4{0.f, 0.f, 0.f, 0.f}; mrow[mi][n] = -1e30f; lrow[mi][n] = 0.f; }
    float4 kreg[4], vreg[4];
#define ATT_LOAD(ti_)                                                                                      \
  do {                                                                                                     \
    const float *kp_, *vp_; int st_;                                                                       \
    if ((ti_) < nloc) { size_t tok0 = seqbase + lo + (ti_) * 64; kp_ = QKV + tok0 * ld + kcol; vp_ = QKV + tok0 * ld + vcol; st_ = ld; } \
    else { int m0 = ((ti_) - nloc) * 64; kp_ = cK + (size_t)m0 * cstride; vp_ = cV + (size_t)m0 * cstride; st_ = cstride; }          \
    _Pragma("unroll") for (int i = 0; i < 4; ++i) {                                                        \
      int idx = tid + 256 * i; int row = idx >> 4, c4 = (idx & 15) * 4;                                    \
      kreg[i] = *(const float4*)(kp_ + (size_t)row * st_ + c4);                                            \
      vreg[i] = *(const float4*)(vp_ + (size_t)(4 * (tid >> 4) + i) * st_ + c4);     \
    }                                                                                                      \
  } while (0)
#define ATT_STORE(buf_)                                                                                    \
  do {                                                                                                     \
    u16* ks_ = Ks + (buf_) * 64 * 72; u16* vt_ = Vt + (buf_) * 64 * 72;                                    \
    _Pragma("unroll") for (int i = 0; i < 4; ++i) {                                                        \
      int idx = tid + 256 * i; int row = idx >> 4, c4 = (idx & 15) * 4;                                    \
      uint2 kb; kb.x = pk2bf(kreg[i].x, kreg[i].y); kb.y = pk2bf(kreg[i].z, kreg[i].w);                    \
      *(uint2*)(ks_ + row * 72 + c4) = kb;                                                                 \
    }                                                                                                      \
    {                                                                                                      \
      const int c4 = (tid & 15) * 4, k4 = 4 * (tid >> 4);                                                  \
      uint2 w0, w1, w2, w3;                                                                                \
      w0.x = pk2bf(vreg[0].x, vreg[1].x); w0.y = pk2bf(vreg[2].x, vreg[3].x);                              \
      w1.x = pk2bf(vreg[0].y, vreg[1].y); w1.y = pk2bf(vreg[2].y, vreg[3].y);                              \
      w2.x = pk2bf(vreg[0].z, vreg[1].z); w2.y = pk2bf(vreg[2].z, vreg[3].z);                              \
      w3.x = pk2bf(vreg[0].w, vreg[1].w); w3.y = pk2bf(vreg[2].w, vreg[3].w);                              \
      *(uint2*)(vt_ + (c4 + 0) * 72 + k4) = w0; *(uint2*)(vt_ + (c4 + 1) * 72 + k4) = w1;                  \
      *(uint2*)(vt_ + (c4 + 2) * 72 + k4) = w2; *(uint2*)(vt_ + (c4 + 3) * 72 + k4) = w3;                  \
    }                                                                                                      \
  } while (0)
    const float sink_l2 = kind == 0 ? p.a_sink[h] * 1.4426950408889634f : 0.f;
    float* rpbs = (float*)(smem + 55296);
    if (kind == 1 && lat)
      for (int i = tid; i < 465; i += 256) rpbs[i] = p.na_rpb[(size_t)h * 465 + i] * 1.4426950408889634f;
    ATT_LOAD(0);
    ATT_STORE(0);
    __syncthreads();
    for (int ti = 0; ti < ntile; ++ti) {
      const int cur = ti & 1;
      const bool more = ti + 1 < ntile;
      if (more) ATT_LOAD(ti + 1);
      const u16* ksb = Ks + cur * 64 * 72;
      const u16* vtb = Vt + cur * 64 * 72;
      const bool local = ti < nloc;
      const int key0 = lo + ti * 64;
      bool wave_on = true;
      if (lat && local && kind == 1) { int kr = rs0 + ti; wave_on = kr >= rsq && kr < rsq + 8; }
      const int skf = (lat && local && kind == 1) ? ((wid & 1) ? 0 : 3) : -1;
      if (wave_on) {
        f32x4 s[2][4];
#pragma unroll
        for (int n = 0; n < 4; ++n) {
          bf16x8 kb0 = *(const bf16x8*)(ksb + (n * 16 + fr) * 72 + fq * 8);
          bf16x8 kb1 = *(const bf16x8*)(ksb + (n * 16 + fr) * 72 + 32 + fq * 8);
#pragma unroll
          for (int mi = 0; mi < 2; ++mi) {
            s[mi][n] = __builtin_amdgcn_mfma_f32_16x16x32_bf16(qf[mi][0], kb0, f32x4{0.f, 0.f, 0.f, 0.f}, 0, 0, 0);
            s[mi][n] = __builtin_amdgcn_mfma_f32_16x16x32_bf16(qf[mi][1], kb1, s[mi][n], 0, 0, 0);
          }
        }
        if (lat && local) {
          if (kind == 0) {
            const int qw = q0 + wid * 32;
            if (key0 + 63 - qw > 128 || qw + 31 - key0 > 128)
#pragma unroll
            for (int mi = 0; mi < 2; ++mi)
#pragma unroll
              for (int n = 0; n < 4; ++n)
#pragma unroll
                for (int j = 0; j < 4; ++j) {
                  int kpos = key0 + n * 16 + fr, qpos = q0 + wid * 32 + mi * 16 + fq * 4 + j;
                  int dlt = kpos - qpos; dlt = dlt < 0 ? -dlt : dlt;
                  if (dlt > 128) s[mi][n][j] = -3e30f;
                }
          } else {
            const int drow = (rs0 + ti) - rq + 7;
            const float* rp = rpbs + drow * 31;
#pragma unroll
            for (int n = 0; n < 4; ++n) {
              if (n == skf) {
#pragma unroll
                for (int mi = 0; mi < 2; ++mi) s[mi][n] = f32x4{-3e30f, -3e30f, -3e30f, -3e30f};
              } else {
#pragma unroll
                for (int mi = 0; mi < 2; ++mi)
#pragma unroll
                  for (int j = 0; j < 4; ++j) {
                    int kc = n * 16 + fr, qc = (wid & 1) * 32 + mi * 16 + fq * 4 + j;
                    int cs = qc - 8; cs = cs < 0 ? 0 : (cs > 48 ? 48 : cs);
                    int dc = kc - qc; dc = dc < -15 ? -15 : (dc > 15 ? 15 : dc);
                    bool ok = kc >= cs && kc < cs + 16;
                    s[mi][n][j] = ok ? s[mi][n][j] + rp[dc + 15] : -3e30f;
                  }
              }
            }
          }
        }
#pragma unroll
        for (int mi = 0; mi < 2; ++mi)
#pragma unroll
          for (int j = 0; j < 4; ++j) {
            float mx = fmaxf(fmaxf(s[mi][0][j], s[mi][1][j]), fmaxf(s[mi][2][j], s[mi][3][j]));
            mx = rowmax16(mx);
            float mnew = fmaxf(mrow[mi][j], mx);
            float alpha = __builtin_amdgcn_exp2f(mrow[mi][j] - mnew);
            mrow[mi][j] = mnew;
            const float p0 = skf == 0 ? 0.f : __builtin_amdgcn_exp2f(s[mi][0][j] - mnew), p1 = __builtin_amdgcn_exp2f(s[mi][1][j] - mnew);
            const float p2 = __builtin_amdgcn_exp2f(s[mi][2][j] - mnew), p3 = skf == 3 ? 0.f : __builtin_amdgcn_exp2f(s[mi][3][j] - mnew);
            const unsigned q01 = pk2bf(p0, p1), q23 = pk2bf(p2, p3);
            u16* prow = Pw + (mi * 16 + fq * 4 + j) * 72 + fr;
            prow[0] = (u16)q01; prow[16] = (u16)(q01 >> 16); prow[32] = (u16)q23; prow[48] = (u16)(q23 >> 16);
#pragma unroll
            for (int n = 0; n < 4; ++n) o[mi][n][j] *= alpha;
            lrow[mi][j] = lrow[mi][j] * alpha + ((p0 + p1) + (p2 + p3));
          }
        asm volatile("s_waitcnt lgkmcnt(0)" ::: "memory");
#pragma unroll
        for (int ks = 0; ks < 2; ++ks) {
          bf16x8 pa0 = *(const bf16x8*)(Pw + fr * 72 + ks * 32 + fq * 8);
          bf16x8 pa1 = *(const bf16x8*)(Pw + (16 + fr) * 72 + ks * 32 + fq * 8);
#pragma unroll
          for (int n = 0; n < 4; ++n) {
            bf16x8 vb = *(const bf16x8*)(vtb + (n * 16 + fr) * 72 + ks * 32 + fq * 8);
            o[0][n] = __builtin_amdgcn_mfma_f32_16x16x32_bf16(pa0, vb, o[0][n], 0, 0, 0);
            o[1][n] = __builtin_amdgcn_mfma_f32_16x16x32_bf16(pa1, vb, o[1][n], 0, 0, 0);
          }
        }
      }
      if (more) ATT_STORE(cur ^ 1);
      __syncthreads();
    }
#undef ATT_LOAD
#undef ATT_STORE
#pragma unroll
    for (int mi = 0; mi < 2; ++mi)
#pragma unroll
      for (int j = 0; j < 4; ++j) {
        float l = rowsum16(lrow[mi][j]);
        float scale;
        if (kind == 0) {
          float sk = sink_l2;
          float mf = fmaxf(mrow[mi][j], sk);
          float sc = __builtin_amdgcn_exp2f(mrow[mi][j] - mf);
          l = l * sc + __builtin_amdgcn_exp2f(sk - mf);
          scale = sc / l;
        } else scale = 1.f / l;
        size_t tok = seqbase + q0 + wid * 32 + mi * 16 + fq * 4 + j;
#pragma unroll
        for (int n = 0; n < 4; ++n) ACT[tok * 1024 + h * 64 + n * 16 + fr] = f2bf(o[mi][n][j] * scale);
      }
  }
}

DEVI void s5_coeffs(const P& p, int d, int g, int lane, float& ar, float& ai, float (&bbr)[16], float (&bbi)[16]) {
  size_t pi = ((size_t)d * 64 + g) * 64 + lane;
  float lre = p.lam_re[pi], lim = p.lam_im[pi];
  float dt = expf(p.log_dt[d * 64 + g]);
  float lr = lre * dt, li = lim * dt;
  float er = expf(lr);
  float sn, cs;
  sincosf(li, &sn, &cs);
  ar = er * cs; ai = er * sn;
  float den = lre * lre + lim * lim;
  float fr_ = ((ar - 1.f) * lre + ai * lim) / den;
  float fi_ = (ai * lre - (ar - 1.f) * lim) / den;
  const float4* br = (const float4*)(p.b_re + pi * 16);
  const float4* bi = (const float4*)(p.b_im + pi * 16);
#pragma unroll
  for (int q = 0; q < 4; ++q) {
    float4 r4 = br[q], i4 = bi[q];
    bbr[q * 4 + 0] = fr_ * r4.x - fi_ * i4.x; bbi[q * 4 + 0] = fr_ * i4.x + fi_ * r4.x;
    bbr[q * 4 + 1] = fr_ * r4.y - fi_ * i4.y; bbi[q * 4 + 1] = fr_ * i4.y + fi_ * r4.y;
    bbr[q * 4 + 2] = fr_ * r4.z - fi_ * i4.z; bbi[q * 4 + 2] = fr_ * i4.z + fi_ * r4.z;
    bbr[q * 4 + 3] = fr_ * r4.w - fi_ * i4.w; bbi[q * 4 + 3] = fr_ * i4.w + fi_ * r4.w;
  }
}

DEVI void s5_phase(const P& p, int mode, int bid, int nb, char* smem, const int tidx) {
  const int tid = tidx, wid = tid >> 6, lane = tid & 63, fr = lane & 15, fq = lane >> 4;
  const float* HF = (const float*)(p.ws + OFF_MIX + MX_HF);
  float* YD = (float*)(p.ws + OFF_MIX + MX_YD);
  float* Ere = (float*)(p.ws + OFF_MIX + MX_E);
  float* Eim = Ere + 128 * 32 * 64;
  char* wb = smem + wid * 19456;
  u16* BBs = (u16*)wb;
  float* bus = (float*)(wb + 6144);
  u16* xs = (u16*)(wb + 6144 + 8448);
  const int ngrp = mode == 0 ? 8 : 12;
  const bf16x8 zero8 = {0, 0, 0, 0, 0, 0, 0, 0};
#define WSYNC() asm volatile("s_waitcnt lgkmcnt(0)" ::: "memory")
  for (int it = bid; it < 128 * ngrp; it += nb) {
    int dg, grp;
    if ((nb & 7) == 0) {
      const int x = it & 7, j = it >> 3, dgl = j / ngrp;
      grp = j % ngrp;
      dg = ((dgl >> 3) << 6) | (8 * x + (dgl & 7));
    } else { dg = it / ngrp; grp = it % ngrp; }
    const int d = dg >> 6, g = dg & 63;
    int cs = grp * 4 + wid;
    if (mode == 0) cs += 16;
    const bool lat = cs >= 16;
    const int lc = cs - 16, bl = lc >> 4, ck = lc & 15;
    const int tb = lat ? TC + bl * 4096 + ck * 256 : cs * 256;
    float ar, ai;
    bf16x8 bfr[8];
    {
      float bbr[16], bbi[16];
      s5_coeffs(p, d, g, lane, ar, ai, bbr, bbi);
      WSYNC();
      *(bf16x8*)(BBs + lane * 24) = pack8(bbr);
      *(bf16x8*)(BBs + lane * 24 + 8) = pack8(bbr + 8);
      *(bf16x8*)(BBs + (64 + lane) * 24) = pack8(bbi);
      *(bf16x8*)(BBs + (64 + lane) * 24 + 8) = pack8(bbi + 8);
      WSYNC();
#pragma unroll
      for (int nf = 0; nf < 8; ++nf) bfr[nf] = fq < 2 ? *(const bf16x8*)(BBs + (nf * 16 + fr) * 24 + fq * 8) : zero8;
    }
    float xr = 0.f, xi = 0.f;
    bf16x8 cb[4];
    if (mode == 1) {
      if (lat) {
        size_t si = (((size_t)bl * 2 + d) * 64 + g) * 64 + lane;
        xr = p.s5_sre[si]; xi = p.s5_sim[si];
        float cr = ar, ci = ai;
#pragma unroll
        for (int q = 0; q < 8; ++q) { float nr = cr * cr - ci * ci, ni = 2.f * cr * ci; cr = nr; ci = ni; }
        const size_t eb = ((size_t)dg * 32 + bl * 16) * 64 + lane;
        if (d == 0) {
          for (int j = 0; j < ck; ++j) {
            float er = Ere[eb + j * 64], ei = Eim[eb + j * 64];
            float nr = cr * xr - ci * xi + er, ni = cr * xi + ci * xr + ei;
            xr = nr; xi = ni;
          }
        } else {
          for (int j = 15; j > ck; --j) {
            float er = Ere[eb + j * 64], ei = Eim[eb + j * 64];
            float nr = cr * xr - ci * xi + er, ni = cr * xi + ci * xr + ei;
            xr = nr; xi = ni;
          }
        }
      }
      const float* cre = p.c_re + (((size_t)d * 64 + g) * 16 + fr) * 64;
      const float* cim = p.c_im + (((size_t)d * 64 + g) * 16 + fr) * 64;
#pragma unroll
      for (int ks = 0; ks < 4; ++ks) {
        const float* src = (ks < 2 ? cre : cim) + (ks & 1) * 32 + fq * 8;
        float sg = ks < 2 ? 1.f : -1.f;
        float v[8];
#pragma unroll
        for (int q = 0; q < 8; ++q) v[q] = sg * src[q];
        cb[ks] = pack8(v);
      }
    }
    float4 u0 = make_float4(0.f, 0.f, 0.f, 0.f), u1 = u0;
    if (fq < 2) {
      const float* up = HF + (size_t)(tb + (d ? 255 - fr : fr)) * 1024 + g * 16 + fq * 8;
      u0 = *(const float4*)up; u1 = *(const float4*)(up + 4);
    }
    for (int sub = 0; sub < 16; ++sub) {
      bf16x8 uf;
      { float v[8] = {u0.x, u0.y, u0.z, u0.w, u1.x, u1.y, u1.z, u1.w}; uf = pack8(v); }
      if (sub + 1 < 16 && fq < 2) {
        int s = (sub + 1) * 16 + fr;
        const float* up = HF + (size_t)(tb + (d ? 255 - s : s)) * 1024 + g * 16 + fq * 8;
        u0 = *(const float4*)up; u1 = *(const float4*)(up + 4);
      }
#pragma unroll
      for (int nf = 0; nf < 8; ++nf) {
        f32x4 bu = __builtin_amdgcn_mfma_f32_16x16x32_bf16(uf, bfr[nf], f32x4{0.f, 0.f, 0.f, 0.f}, 0, 0, 0);
#pragma unroll
        for (int j = 0; j < 4; ++j) bus[(fq * 4 + j) * 132 + nf * 16 + fr] = bu[j];
      }
      WSYNC();
#pragma unroll
      for (int t = 0; t < 16; ++t) {
        float bur = bus[t * 132 + lane], bui = bus[t * 132 + 64 + lane];
        float nr = ar * xr - ai * xi + bur, ni = ar * xi + ai * xr + bui;
        xr = nr; xi = ni;
        if (mode == 1) { xs[t * 136 + lane] = f2bf(xr); xs[t * 136 + 64 + lane] = f2bf(xi); }
      }
      if (mode == 1) {
        WSYNC();
        f32x4 acc = f32x4{0.f, 0.f, 0.f, 0.f};
#pragma unroll
        for (int ks = 0; ks < 4; ++ks) {
          bf16x8 a = *(const bf16x8*)(xs + fr * 136 + ks * 32 + fq * 8);
          acc = __builtin_amdgcn_mfma_f32_16x16x32_bf16(a, cb[ks], acc, 0, 0, 0);
        }
#pragma unroll
        for (int j = 0; j < 4; ++j) {
          int s = sub * 16 + fq * 4 + j;
          int tok = tb + (d ? 255 - s : s);
          YD[((size_t)d * T + tok) * 1024 + g * 16 + fr] = acc[j];
        }
      }
      asm volatile("" ::: "memory");
    }
    if (mode == 0) {
      size_t ei = ((size_t)dg * 32 + lc) * 64 + lane;
      Ere[ei] = xr; Eim[ei] = xi;
    } else if (!lat) {
      size_t oi = (((size_t)cs * 2 + d) * 64 + g) * 64 + lane;
      p.out[OUT_SRE + oi] = xr; p.out[OUT_SIM + oi] = xi;
    }
  }
#undef WSYNC
}

DEVI void s5c_phase(const P& p, int bid, int nb, const int tidx) {
  const float* HF = (const float*)(p.ws + OFF_MIX + MX_HF);
  const float* Y0 = (const float*)(p.ws + OFF_MIX + MX_YD);
  const float* Y1 = Y0 + (size_t)T * 1024;
  u16* ACT = (u16*)(p.ws + OFF_ACT);
  for (size_t i = (size_t)bid * 256 + tidx; i < (size_t)T * 256; i += (size_t)nb * 256) {
    int e = (int)(i & 255) * 4;
    float4 a = ((const float4*)Y0)[i], b = ((const float4*)Y1)[i], h = ((const float4*)HF)[i], dk = *(const float4*)(p.s5_d + e);
    float v[4] = {a.x + b.x + dk.x * h.x, a.y + b.y + dk.y * h.y, a.z + b.z + dk.z * h.z, a.w + b.w + dk.w * h.w};
    u16 o[4];
#pragma unroll
    for (int q = 0; q < 4; ++q) {
      float x = v[q];
      float t = tanhf(0.7978845608028654f * (x + 0.044715f * x * x * x));
      o[q] = f2bf(0.5f * x * (1.f + t));
    }
    uint2 ob; ob.x = o[0] | ((unsigned)o[1] << 16); ob.y = o[2] | ((unsigned)o[3] << 16);
    ((uint2*)ACT)[i] = ob;
  }
}

DEVI void dna_phase(const P& p, int bid, int nb, const int tidx) {
  const int wave = tidx >> 6, lane = tidx & 63;
  const float* RAW = (const float*)(p.ws + OFF_MIX + MX_RAW);
  const float* ZB = (const float*)(p.ws + OFF_MIX + MX_ZB);
  float* QC = (float*)(p.ws + OFF_MIX + MX_QC);
  float* KC = (float*)(p.ws + OFF_MIX + MX_KC);
  float* VC = (float*)(p.ws + OFF_MIX + MX_VC);
  float* BETA = (float*)(p.ws + OFF_MIX + MX_BETA);
  float* G = (float*)(p.ws + OFF_MIX + MX_G);
  for (int t0 = (bid * 4 + wave) * 4; t0 < T; t0 += nb * 16) {
    int base, L;
    if (t0 < TC) { base = t0 & ~255; L = 256; } else { base = TC + (((t0 - TC) >> 12) << 12); L = 4096; }
    const int pos0 = t0 - base;
#pragma unroll 2
    for (int r = 0; r < 8; ++r) {
      const int ch = r * 256 + lane * 4;
      float4 x[8], w[5];
#pragma unroll
      for (int k = 0; k < 8; ++k) {
        int pp = pos0 - 2 + k;
        x[k] = (pp >= 0 && pp < L) ? *(const float4*)(RAW + (size_t)(base + pp) * 2048 + ch) : make_float4(0.f, 0.f, 0.f, 0.f);
      }
#pragma unroll
      for (int j = 0; j < 5; ++j) w[j] = *(const float4*)(p.dn_conv + (size_t)j * 2048 + ch);
#pragma unroll
      for (int u = 0; u < 4; ++u) {
        float4 a = make_float4(0.f, 0.f, 0.f, 0.f);
#pragma unroll
        for (int j = 0; j < 5; ++j) {
          a.x += w[j].x * x[u + j].x; a.y += w[j].y * x[u + j].y; a.z += w[j].z * x[u + j].z; a.w += w[j].w * x[u + j].w;
        }
        a.x = a.x / (1.f + __expf(-a.x)); a.y = a.y / (1.f + __expf(-a.y)); a.z = a.z / (1.f + __expf(-a.z)); a.w = a.w / (1.f + __expf(-a.w));
        const int t = t0 + u;
        if (r < 4) {
          float ss = a.x * a.x + a.y * a.y + a.z * a.z + a.w * a.w;
          ss += __shfl_xor(ss, 1); ss += __shfl_xor(ss, 2); ss += __shfl_xor(ss, 4); ss += __shfl_xor(ss, 8); ss += __shfl_xor(ss, 16);
          float sc = rsqrtf(ss + 1e-6f);
          if (r < 2) sc *= 0.08838834764831845f;
          a.x *= sc; a.y *= sc; a.z *= sc; a.w *= sc;
          float* dst = r < 2 ? QC + (size_t)t * 512 + ch : KC + (size_t)t * 512 + (ch - 512);
          *(float4*)dst = a;
        } else {
          *(float4*)(VC + (size_t)t * 1024 + (ch - 1024)) = a;
        }
      }
    }
    {
#pragma unroll
      for (int half = 0; half < 2; ++half) {
        const int u = half * 2 + (lane >> 5), idx = lane & 31;
        const int t = t0 + u, d = idx >> 4, rr = idx & 15;
        float raw = ZB[(size_t)t * 1280 + 1024 + d * 16 + rr];
        if (rr < 8) BETA[((size_t)d * T + t) * 8 + rr] = sigmoidf_(raw);
        else {
          int h = rr - 8;
          float xx = raw + p.dn_dtb[d * 8 + h];
          float sp = xx > 20.f ? xx : log1pf(expf(xx));
          G[((size_t)d * T + t) * 8 + h] = -expf(p.dn_alog[d * 8 + h]) * sp;
        }
      }
    }
  }
}

DEVI void dn_cs(int cs, int& base, int& L, int& n) {
  if (cs < 64) { base = (cs >> 2) * 256; L = 256; n = cs & 3; }
  else { int j = cs - 64; base = TC + (j >> 6) * 4096; L = 4096; n = j & 63; }
}

constexpr size_t DN_HALF = (size_t)3072 * 64 * 128 * 2;
DEVI void dnb_phase(const P& p, int bid, int nb, char* smem, const int tidx) {
  const int tid = tidx;
  const float* QC = (const float*)(p.ws + OFF_MIX + MX_QC);
  const float* KC = (const float*)(p.ws + OFF_MIX + MX_KC);
  const float* VC = (const float*)(p.ws + OFF_MIX + MX_VC);
  const float* BETA = (const float*)(p.ws + OFF_MIX + MX_BETA);
  const float* G = (const float*)(p.ws + OFF_MIX + MX_G);
  u16* Ub = (u16*)(p.ws + OFF_MIX + MX_RAW);
  u16* KdT = (u16*)(p.ws + OFF_MIX + MX_RAW + DN_HALF);
  u16* Wb = (u16*)(p.ws + OFF_MIX + MX_W);
  u16* Qg = (u16*)(p.ws + OFF_MIX + MX_W + DN_HALF);
  u16* Ab = (u16*)(p.ws + OFF_ACT + AX_AQK);
  float* GC = (float*)(p.ws + OFF_ACT + AX_GC);
  u16* Kb = (u16*)smem;
  u16* Qb = Kb + 64 * 136;
  float* Lm = (float*)(Qb + 64 * 136);
  float* gcs = Lm + 64 * 64;
  float* bts = gcs + 64;
  int* toks = (int*)(bts + 64);
  float* egs = (float*)(toks + 64);
  float* eds = egs + 64;
  float* sol = eds + 64;
  const int wid = tid >> 6, lane = tid & 63, fr = lane & 15, fq = lane >> 4;
  for (int it0 = bid; it0 < 3072; it0 += nb) {
    const int it = (nb & 7) == 0 ? ((((it0 >> 3) >> 4) * 8 + (it0 & 7)) << 4) | ((it0 >> 3) & 15) : it0;
    const int cs = it >> 4, h = (it >> 1) & 7, d = it & 1, hk = h >> 1;
    int base, L, n;
    dn_cs(cs, base, L, n);
    __syncthreads();
    if (tid < 64) {
      int pos = n * 64 + tid;
      int tok = base + (d ? L - 1 - pos : pos);
      toks[tid] = tok;
      float g = G[((size_t)d * T + tok) * 8 + h];
      bts[tid] = BETA[((size_t)d * T + tok) * 8 + h];
#pragma unroll
      for (int o = 1; o < 64; o <<= 1) { float v = __shfl_up(g, o); if (tid >= o) g += v; }
      gcs[tid] = g;
      GC[(size_t)it * 64 + tid] = g;
      egs[tid] = expf(g);
      eds[tid] = expf(__shfl(g, 63) - g);
    }
    __syncthreads();
#pragma unroll
    for (int i = 0; i < 8; ++i) {
      int idx = tid + 256 * i;
      int row = idx >> 5, c4 = (idx & 31) * 4;
      float4 kv = *(const float4*)(KC + (size_t)toks[row] * 512 + hk * 128 + c4);
      float4 qv = *(const float4*)(QC + (size_t)toks[row] * 512 + hk * 128 + c4);
      uint2 kb, qb, qg;
      kb.x = f2bf(kv.x) | ((unsigned)f2bf(kv.y) << 16); kb.y = f2bf(kv.z) | ((unsigned)f2bf(kv.w) << 16);
      qb.x = f2bf(qv.x) | ((unsigned)f2bf(qv.y) << 16); qb.y = f2bf(qv.z) | ((unsigned)f2bf(qv.w) << 16);
      const float eg = egs[row];
      qg.x = f2bf(qv.x * eg) | ((unsigned)f2bf(qv.y * eg) << 16); qg.y = f2bf(qv.z * eg) | ((unsigned)f2bf(qv.w * eg) << 16);
      *(uint2*)(Kb + row * 136 + c4) = kb;
      *(uint2*)(Qb + row * 136 + c4) = qb;
      *(uint2*)(Qg + ((size_t)it * 64 + row) * 128 + c4) = qg;
    }
    __syncthreads();
    {
      f32x4 kk[4], qk[4];
#pragma unroll
      for (int nn = 0; nn < 4; ++nn) { kk[nn] = f32x4{0.f, 0.f, 0.f, 0.f}; qk[nn] = f32x4{0.f, 0.f, 0.f, 0.f}; }
#pragma unroll
      for (int ks = 0; ks < 4; ++ks) {
        bf16x8 ka = *(const bf16x8*)(Kb + (wid * 16 + fr) * 136 + ks * 32 + fq * 8);
        bf16x8 qa = *(const bf16x8*)(Qb + (wid * 16 + fr) * 136 + ks * 32 + fq * 8);
#pragma unroll
        for (int nn = 0; nn < 4; ++nn) {
          if (nn <= wid) {
            bf16x8 kbf = *(const bf16x8*)(Kb + (nn * 16 + fr) * 136 + ks * 32 + fq * 8);
            kk[nn] = __builtin_amdgcn_mfma_f32_16x16x32_bf16(ka, kbf, kk[nn], 0, 0, 0);
            qk[nn] = __builtin_amdgcn_mfma_f32_16x16x32_bf16(qa, kbf, qk[nn], 0, 0, 0);
          }
        }
      }
      __syncthreads();
      float* LmT = (float*)Qb;
#pragma unroll
      for (int nn = 0; nn < 4; ++nn)
#pragma unroll
        for (int jj = 0; jj < 4; ++jj) {
          const int i = wid * 16 + fq * 4 + jj, j = nn * 16 + fr;
          const float dec = i >= j ? expf(gcs[i] - gcs[j]) : 0.f;
          const float lv = i > j ? bts[i] * kk[nn][jj] * dec : 0.f;
          Lm[i * 64 + j] = lv;
          LmT[j * 64 + i] = lv;
          Ab[((size_t)it * 64 + i) * 64 + j] = f2bf(qk[nn][jj] * dec);
        }
      {
        const int dd = tid >> 1, hf = tid & 1;
        u16* kd = KdT + ((size_t)it * 128 + dd) * 64 + hf * 32;
#pragma unroll
        for (int q8 = 0; q8 < 4; ++q8) {
          float v[8];
#pragma unroll
          for (int q = 0; q < 8; ++q) { int c = hf * 32 + q8 * 8 + q; v[q] = __uint_as_float((unsigned)Kb[c * 136 + dd] << 16) * eds[c]; }
          uint4 o;
          o.x = f2bf(v[0]) | ((unsigned)f2bf(v[1]) << 16); o.y = f2bf(v[2]) | ((unsigned)f2bf(v[3]) << 16);
          o.z = f2bf(v[4]) | ((unsigned)f2bf(v[5]) << 16); o.w = f2bf(v[6]) | ((unsigned)f2bf(v[7]) << 16);
          *(uint4*)(kd + q8 * 8) = o;
        }
      }
    }
    __syncthreads();
    {
      const int c = tid;
      const bool isU = c < 128;
      u16* dst = isU ? Ub + ((size_t)it * 128 + c) * 64 : Wb + (size_t)it * 64 * 128 + (c - 128);
      const float* rsrc = isU ? VC + h * 128 + c : KC + hk * 128 + (c - 128);
      const int rstride = isU ? 1024 : 512;
      float rhs[64];
#pragma unroll
      for (int i = 0; i < 64; ++i) rhs[i] = rsrc[(size_t)toks[i] * rstride];
#pragma unroll
      for (int rb = 0; rb < 4; ++rb) {
        float acc[16];
#pragma unroll
        for (int ii = 0; ii < 16; ++ii) {
          int i = rb * 16 + ii;
          float bt = bts[i];
          float f = isU ? bt : bt * egs[i];
          acc[ii] = rhs[i] * f;
        }
        for (int j = 0; j < rb * 16; ++j) {
          const float s = sol[j * 256 + c];
          const float4* lt = (const float4*)((const float*)Qb + j * 64 + rb * 16);
#pragma unroll
          for (int q4 = 0; q4 < 4; ++q4) {
            const float4 l4 = lt[q4];
            acc[q4 * 4 + 0] -= l4.x * s; acc[q4 * 4 + 1] -= l4.y * s; acc[q4 * 4 + 2] -= l4.z * s; acc[q4 * 4 + 3] -= l4.w * s;
          }
        }
#pragma unroll
        for (int ii = 0; ii < 16; ++ii) {
#pragma unroll
          for (int jj = 0; jj < ii; ++jj) acc[ii] -= Lm[(rb * 16 + ii) * 64 + rb * 16 + jj] * acc[jj];
          sol[(rb * 16 + ii) * 256 + c] = acc[ii];
          if (isU) dst[rb * 16 + ii] = f2bf(acc[ii]);
          else dst[(rb * 16 + ii) * 128] = f2bf(acc[ii]);
        }
      }
    }
  }
}

DEVI void dnc_phase(const P& p, int bid, int nb, char* smem, const int tidx) {
  const int tid = tidx, wid = tid >> 6, lane = tid & 63, fr = lane & 15, fq = lane >> 4;
  const u16* Ub = (const u16*)(p.ws + OFF_MIX + MX_RAW);
  const u16* KdT = (const u16*)(p.ws + OFF_MIX + MX_RAW + DN_HALF);
  const u16* Wb = (const u16*)(p.ws + OFF_MIX + MX_W);
  const u16* Qg = (const u16*)(p.ws + OFF_MIX + MX_W + DN_HALF);
  const u16* Ab = (const u16*)(p.ws + OFF_ACT + AX_AQK);
  const float* GC = (const float*)(p.ws + OFF_ACT + AX_GC);
  float* O0 = (float*)(p.ws + OFF_Y);
  float* O1 = (float*)(p.ws + OFF_MIX + MX_O1);
  u16* St = (u16*)smem;
  u16* Vt = St + 32 * 136;
  int it, nit, step;
  if (nb >= 256) { if (bid < 128) { it = bid; nit = 1; } else if (bid < 256) { it = bid; nit = 8; } else { it = 0; nit = 0; } step = 128; }
  else { it = bid; nit = (1152 - bid + nb - 1) / nb; step = nb; }
  for (int ii = 0; ii < nit; ++ii, it += step) {
    int chain, sq, sl;
    if ((nb & 7) == 0) {
      const int jb = it < 128 ? it : it - 128;
      const int x = jb & 7, j = jb >> 3;
      sl = j & 3;
      chain = (j >> 2) * 8 + x;
    } else { sl = it & 3; chain = it < 128 ? it >> 2 : (it - 128) >> 2; }
    sq = it < 128 ? 16 + (chain >> 4) : chain >> 4;
    const int h = (chain >> 1) & 7, d = chain & 1, e0 = sl * 32;
    const bool lat = sq >= 16;
    const int nch = lat ? 64 : 4;
    const int csb = lat ? 64 + (sq - 16) * 64 : sq * 4;
    const int tokbase = lat ? TC + (sq - 16) * 4096 : sq * 256;
    const int L = lat ? 4096 : 256;
    float* Od = d ? O1 : O0;
    f32x4 S_[2][2];
#pragma unroll
    for (int mi = 0; mi < 2; ++mi)
#pragma unroll
      for (int ni = 0; ni < 2; ++ni) {
        if (lat) {
          const float* s0 = p.state_dn + ((((size_t)(sq - 16) * 2 + d) * 8 + h) * 128) * 128;
#pragma unroll
          for (int j = 0; j < 4; ++j) S_[mi][ni][j] = s0[(size_t)((2 * wid + mi) * 16 + fq * 4 + j) * 128 + e0 + ni * 16 + fr];
        } else S_[mi][ni] = f32x4{0.f, 0.f, 0.f, 0.f};
      }
    __syncthreads();
#pragma unroll
    for (int mi = 0; mi < 2; ++mi)
#pragma unroll
      for (int ni = 0; ni < 2; ++ni) {
        uint2 sv;
        sv.x = f2bf(S_[mi][ni][0]) | ((unsigned)f2bf(S_[mi][ni][1]) << 16);
        sv.y = f2bf(S_[mi][ni][2]) | ((unsigned)f2bf(S_[mi][ni][3]) << 16);
        *(uint2*)(St + (ni * 16 + fr) * 136 + (2 * wid + mi) * 16 + fq * 4) = sv;
      }
    bf16x8 Wf[3][4], Qf[3][4], Af[3][2], Kf[3][2][2];
    uint2 uu[3][2]; float gl[3];
#define DNC_LOAD(nn, S)                                                                                                \
  do {                                                                                                                 \
    const size_t ib_ = ((size_t)(csb + (nn)) * 8 + h) * 2 + d;                                                         \
    _Pragma("unroll") for (int ks = 0; ks < 4; ++ks) {                                                                 \
      Wf[S][ks] = *(const bf16x8*)(Wb + (ib_ * 64 + wid * 16 + fr) * 128 + ks * 32 + fq * 8);                          \
      Qf[S][ks] = *(const bf16x8*)(Qg + (ib_ * 64 + wid * 16 + fr) * 128 + ks * 32 + fq * 8);                          \
    }                                                                                                                  \
    _Pragma("unroll") for (int ks = 0; ks < 2; ++ks) {                                                                 \
      Af[S][ks] = *(const bf16x8*)(Ab + (ib_ * 64 + wid * 16 + fr) * 64 + ks * 32 + fq * 8);                           \
      Kf[S][0][ks] = *(const bf16x8*)(KdT + (ib_ * 128 + (2 * wid) * 16 + fr) * 64 + ks * 32 + fq * 8);                \
      Kf[S][1][ks] = *(const bf16x8*)(KdT + (ib_ * 128 + (2 * wid + 1) * 16 + fr) * 64 + ks * 32 + fq * 8);            \
    }                                                                                                                  \
    _Pragma("unroll") for (int ni = 0; ni < 2; ++ni)                                                                   \
        uu[S][ni] = *(const uint2*)(Ub + (ib_ * 128 + e0 + ni * 16 + fr) * 64 + wid * 16 + fq * 4);                   \
    gl[S] = GC[ib_ * 64 + 63];                                                                                         \
  } while (0)
#define DNC_STEP(n, S)                                                                                                 \
  do {                                                                                                                 \
    const float eg = expf(gl[S]);                                                                                      \
    f32x4 vs[2], o[2];                                                                                                 \
    _Pragma("unroll") for (int ni = 0; ni < 2; ++ni) {                                                                 \
      vs[ni] = f32x4{0.f, 0.f, 0.f, 0.f}; o[ni] = f32x4{0.f, 0.f, 0.f, 0.f};                                           \
      _Pragma("unroll") for (int ks = 0; ks < 4; ++ks) {                                                               \
        bf16x8 sf = *(const bf16x8*)(St + (ni * 16 + fr) * 136 + ks * 32 + fq * 8);                                    \
        vs[ni] = __builtin_amdgcn_mfma_f32_16x16x32_bf16(Wf[S][ks], sf, vs[ni], 0, 0, 0);                              \
        o[ni] = __builtin_amdgcn_mfma_f32_16x16x32_bf16(Qf[S][ks], sf, o[ni], 0, 0, 0);                                \
      }                                                                                                                \
    }                                                                                                                  \
    _Pragma("unroll") for (int ni = 0; ni < 2; ++ni) {                                                                 \
      uint2 vv;                                                                                                        \
      const float u0_ = __uint_as_float(uu[S][ni].x << 16), u1_ = __uint_as_float(uu[S][ni].x & 0xffff0000u);         \
      const float u2_ = __uint_as_float(uu[S][ni].y << 16), u3_ = __uint_as_float(uu[S][ni].y & 0xffff0000u);         \
      vv.x = pk2bf(u0_ - vs[ni][0], u1_ - vs[ni][1]);                                                                  \
      vv.y = pk2bf(u2_ - vs[ni][2], u3_ - vs[ni][3]);                                                                  \
      *(uint2*)(Vt + (ni * 16 + fr) * 72 + wid * 16 + fq * 4) = vv;                                                    \
    }                                                                                                                  \
    LBAR();                                                                                                           \
    bf16x8 vf[2][2];                                                                                                   \
    _Pragma("unroll") for (int ni = 0; ni < 2; ++ni)                                                                   \
    _Pragma("unroll") for (int ks = 0; ks < 2; ++ks) vf[ni][ks] = *(const bf16x8*)(Vt + (ni * 16 + fr) * 72 + ks * 32 + fq * 8); \
    _Pragma("unroll") for (int ni = 0; ni < 2; ++ni) {                                                                 \
      _Pragma("unroll") for (int ks = 0; ks < 2; ++ks) o[ni] = __builtin_amdgcn_mfma_f32_16x16x32_bf16(Af[S][ks], vf[ni][ks], o[ni], 0, 0, 0); \
      _Pragma("unroll") for (int j = 0; j < 4; ++j) {                                                                  \
        int pos = (n) * 64 + wid * 16 + fq * 4 + j;                                                                    \
        int tok = tokbase + (d ? L - 1 - pos : pos);                                                                   \
        Od[(size_t)tok * 1024 + h * 128 + e0 + ni * 16 + fr] = o[ni][j];                                               \
      }                                                                                                                \
    }                                                                                                                  \
    _Pragma("unroll") for (int mi = 0; mi < 2; ++mi)                                                                   \
    _Pragma("unroll") for (int ni = 0; ni < 2; ++ni) {                                                                 \
      S_[mi][ni] = S_[mi][ni] * eg;                                                                                    \
      _Pragma("unroll") for (int ks = 0; ks < 2; ++ks) S_[mi][ni] = __builtin_amdgcn_mfma_f32_16x16x32_bf16(Kf[S][mi][ks], vf[ni][ks], S_[mi][ni], 0, 0, 0); \
      uint2 sv;                                                                                                        \
      sv.x = pk2bf(S_[mi][ni][0], S_[mi][ni][1]);                                                                      \
      sv.y = pk2bf(S_[mi][ni][2], S_[mi][ni][3]);                                                                      \
      *(uint2*)(St + (ni * 16 + fr) * 136 + (2 * wid + mi) * 16 + fq * 4) = sv;                                        \
    }                                                                                                                  \
    LBAR();                                                                                                           \
  } while (0)
#define NCL(x) ((x) < nch ? (x) : nch - 1)
    DNC_LOAD(0, 0);
    DNC_LOAD(1, 1);
    __syncthreads();
    int n = 0;
    for (; n + 2 < nch; n += 3) {
      DNC_LOAD(NCL(n + 2), 2); DNC_STEP(n, 0);
      DNC_LOAD(NCL(n + 3), 0); DNC_STEP(n + 1, 1);
      DNC_LOAD(NCL(n + 4), 1); DNC_STEP(n + 2, 2);
    }
    DNC_STEP(n, 0);
#undef NCL
#undef DNC_STEP
#undef DNC_LOAD
    if (!lat) {
      float* dst = p.out + OUT_DN + ((((size_t)sq * 2 + d) * 8 + h) * 128) * 128;
#pragma unroll
      for (int mi = 0; mi < 2; ++mi)
#pragma unroll
        for (int ni = 0; ni < 2; ++ni)
#pragma unroll
          for (int j = 0; j < 4; ++j) dst[(size_t)((2 * wid + mi) * 16 + fq * 4 + j) * 128 + e0 + ni * 16 + fr] = S_[mi][ni][j];
    }
  }
}

DEVI void dnd_phase(const P& p, int bid, int nb, const int tidx) {
  const int wave = tidx >> 6, lane = tidx & 63;
  const float* O0 = (const float*)(p.ws + OFF_Y);
  const float* O1 = (const float*)(p.ws + OFF_MIX + MX_O1);
  const float* ZB = (const float*)(p.ws + OFF_MIX + MX_ZB);
  u16* ACT = (u16*)(p.ws + OFF_ACT);
  const float2 og = *(const float2*)(p.dn_outg + lane * 2);
  for (int t = bid * 4 + wave; t < T; t += nb * 4) {
    float2 av[8], bv[8], zv[8];
#pragma unroll
    for (int h = 0; h < 8; ++h) {
      int ch = h * 128 + lane * 2;
      av[h] = *(const float2*)(O0 + (size_t)t * 1024 + ch);
      bv[h] = *(const float2*)(O1 + (size_t)t * 1024 + ch);
      zv[h] = *(const float2*)(ZB + (size_t)t * 1280 + ch);
    }
#pragma unroll
    for (int h = 0; h < 8; ++h) {
      int ch = h * 128 + lane * 2;
      float o0 = av[h].x + bv[h].x, o1 = av[h].y + bv[h].y;
      float ss = wsum(o0 * o0 + o1 * o1);
      float rinv = rsqrtf(ss * (1.f / 128.f) + 1e-6f);
      float r0 = o0 * rinv * og.x * (zv[h].x / (1.f + __expf(-zv[h].x)));
      float r1 = o1 * rinv * og.y * (zv[h].y / (1.f + __expf(-zv[h].y)));
      *(unsigned*)(ACT + (size_t)t * 1024 + ch) = pk2bf(r0, r1);
    }
  }
}

#define XB_TMO      128
#define XB_XCNT(j)  (256  + 64 * (j))
#define XB_XSUB(j)  (1280 + 64 * (j))
#define XB_XGEN(j)  (2304 + 64 * (j))
#define XB_TOP      3328
#define XB_TOPGEN   3392
#define XCD_BAR_WORDS 3456
#define XB_SPIN_CAP (1u << 18)
#define LAS __attribute__((address_space(3)))
DEVI unsigned xb_ld(unsigned* p) { return __hip_atomic_load(p, __ATOMIC_RELAXED, __HIP_MEMORY_SCOPE_AGENT); }
DEVI unsigned xb_add(unsigned* p, unsigned v) { return __hip_atomic_fetch_add(p, v, __ATOMIC_RELAXED, __HIP_MEMORY_SCOPE_AGENT); }
DEVI unsigned xb_xcc_id() { return (unsigned)__builtin_amdgcn_s_getreg((3 << 11) | 20) & 0xFu; }
#define XB_SPIN(cond, bar) do { unsigned _sp = 0; while (cond) { __builtin_amdgcn_s_sleep(1); \
    if ((++_sp & 255u) == 0u) { if (xb_ld(&(bar)[XB_TMO])) break; if (_sp > XB_SPIN_CAP) { atomicAdd(&(bar)[XB_TMO], 1u); break; } } } } while (0)
struct XcdBarrier { unsigned* bar; unsigned x; volatile LAS unsigned* st; };
DEVI XcdBarrier xcd_barrier_post(unsigned* bar, volatile LAS unsigned* st) {
  XcdBarrier b; b.bar = bar; b.x = xb_xcc_id(); b.st = st;
  if (threadIdx.x == 0) (void)xb_add(&bar[XB_XCNT(b.x)], 1u);
  return b;
}
DEVI void xcd_barrier_complete(unsigned* bar, unsigned x, unsigned& nloc, unsigned& nx) {
  const unsigned G = gridDim.x * gridDim.y * gridDim.z;
  unsigned sum, cnt, mine, sp = 0u;
  for (;;) {
    sum = 0u; cnt = 0u; mine = 0u;
#pragma unroll
    for (unsigned j = 0; j < 16; ++j) { const unsigned c = xb_ld(&bar[XB_XCNT(j)]); sum += c; cnt += (c > 0u) ? 1u : 0u; mine = (j == x) ? c : mine; }
    if (sum == G) break;
    __builtin_amdgcn_s_sleep(1);
    if ((++sp & 255u) == 0u) { if (xb_ld(&bar[XB_TMO])) break; if (sp > XB_SPIN_CAP) { atomicAdd(&bar[XB_TMO], 1u); break; } }
  }
  nloc = mine > 0u ? mine : 1u; nx = cnt > 0u ? cnt : 1u;
}
DEVI void xcd_barrier(const XcdBarrier& b) {
  asm volatile("s_waitcnt vmcnt(0)" ::: "memory");
  __syncthreads();
  if (threadIdx.x == 0) {
    unsigned* bar = b.bar;
    __builtin_amdgcn_s_waitcnt(0);
    unsigned nloc = b.st[0], nx = b.st[1];
    if (nloc == 0u) { xcd_barrier_complete(bar, b.x, nloc, nx); b.st[0] = nloc; b.st[1] = nx; }
    const unsigned old = xb_add(&bar[XB_XSUB(b.x)], 1u);
    const unsigned gen = old / nloc;
    if (old + 1u == (gen + 1u) * nloc) {
      __builtin_amdgcn_fence(__ATOMIC_RELEASE, "agent");
      asm volatile("s_waitcnt vmcnt(0)" ::: "memory");
      const unsigned og = xb_add(&bar[XB_TOP], 1u);
      const unsigned tg = og / nx;
      if (og + 1u == (tg + 1u) * nx) xb_add(&bar[XB_TOPGEN], 1u);
      else XB_SPIN(xb_ld(&bar[XB_TOPGEN]) == tg, bar);
      __builtin_amdgcn_fence(__ATOMIC_ACQUIRE, "agent");
      xb_add(&bar[XB_XGEN(b.x)], 1u);
      asm volatile("s_waitcnt vmcnt(0)" ::: "memory");
    } else {
      XB_SPIN(xb_ld(&bar[XB_XGEN(b.x)]) == gen, bar);
      __builtin_amdgcn_fence(__ATOMIC_ACQUIRE, "agent");
      asm volatile("s_waitcnt vmcnt(0)" ::: "memory");
    }
  }
  __syncthreads();
}

enum { K_PREP = 0, K_RN, K_G1, K_G2, K_ATTN, K_S5A, K_S5B, K_S5C, K_DNA, K_DNB, K_DNC, K_DND };
__constant__ unsigned char PROG[NPH][2] = {
    {K_PREP, 0},
    {K_RN, 0}, {K_G1, 0}, {K_G2, 0},
    {K_RN, 1}, {K_G1, 1}, {K_ATTN, 0}, {K_G2, 1},
    {K_RN, 2}, {K_G1, 2}, {K_G2, 2},
    {K_RN, 3}, {K_G1, 3}, {K_G2, 3},
    {K_RN, 4}, {K_S5A, 0}, {K_S5B, 0}, {K_S5C, 0}, {K_G2, 4},
    {K_RN, 5}, {K_G1, 5}, {K_G2, 5},
    {K_RN, 6}, {K_G1, 6}, {K_G2, 6},
    {K_RN, 7}, {K_G1, 7}, {K_ATTN, 1}, {K_G2, 7},
    {K_RN, 8}, {K_G1, 8}, {K_G2, 8},
    {K_RN, 9}, {K_G1, 9}, {K_G2, 9},
    {K_RN, 10}, {K_G1, 10}, {K_DNA, 0}, {K_DNB, 0}, {K_DNC, 0}, {K_DND, 0}, {K_G2, 10},
    {K_RN, 11}, {K_G1, 11}, {K_G2, 11},
    {K_RN, 12}};

__global__ void __launch_bounds__(256) mega(P pk) {
  extern __shared__ __attribute__((aligned(16))) char smem[];
  cg::grid_group grid = cg::this_grid();
  __shared__ uint4 xb_words;
  if (threadIdx.x == 0) xb_words = make_uint4(0u, 0u, 0u, 0u);
  __syncthreads();
  XcdBarrier xb = xcd_barrier_post((unsigned*)(pk.ws + OFF_BAR), (volatile LAS unsigned*)&xb_words);
  const P& p = pk;
  const int plo = pk.lo, phi = pk.hi;
  for (int ph = plo; ph < phi; ++ph) {
    int tidx = threadIdx.x, bid = blockIdx.x, nb = gridDim.x;
    asm volatile("" : "+s"(bid), "+s"(nb));
    asm volatile("" : "+v"(tidx));
    char* ws = p.ws;
    const int kind = PROG[ph][0], arg = PROG[ph][1];
    if (kind == K_G1 || kind == K_G2) {
      const int i = arg / 3, s = arg % 3;
      const u16* A; const u16* Wt; int lda = 1024, K = 1024, N = 1024, epi = (kind == K_G1 ? EPI_F32 : EPI_YBF), ldc = 1024;
      float* of = (float*)(ws + OFF_Y); float* of2 = nullptr;
      if (kind == K_G1) {
        A = (const u16*)(ws + OFF_H);
        of = (float*)(ws + OFF_MIX);
        if (s != 1) { Wt = (const u16*)(ws + OFF_WT_GU) + (size_t)(i * 2 + (s >> 1)) * 5632 * 1024; N = 5632; epi = EPI_SWIGLU; }
        else if (i == 0) { Wt = (const u16*)(ws + OFF_WT_AQKV); N = 1536; epi = EPI_ROPE; ldc = 1536; }
        else if (i == 2) { Wt = (const u16*)(ws + OFF_WT_NQKV); N = 3072; ldc = 3072; }
        else { Wt = (const u16*)(ws + OFF_WT_DIN); N = 3328; epi = EPI_SPLIT; of = (float*)(ws + OFF_MIX + MX_RAW); of2 = (float*)(ws + OFF_MIX + MX_ZB); }
      } else {
        A = (const u16*)(ws + OFF_ACT);
        if (s != 1) { Wt = (const u16*)(ws + OFF_WT_D) + (size_t)(i * 2 + (s >> 1)) * 1024 * 2816; lda = 2816; K = 2816; }
        else if (i == 0) Wt = (const u16*)(ws + OFF_WT_AO);
        else if (i == 1) { Wt = (const u16*)(ws + OFF_WT_GLU); N = 2048; epi = EPI_GLU; }
        else if (i == 2) Wt = (const u16*)(ws + OFF_WT_NO);
        else Wt = (const u16*)(ws + OFF_WT_DO);
      }
      gemm_phase(A, lda, Wt, K, N, epi, of, ldc, (u16*)(ws + OFF_ACT), of2, bid, nb, smem, tidx);
    } else if (kind == K_RN) {
      const int sub = arg;
      const int pi = sub > 0 ? (sub - 1) / 3 : -1, ps = sub > 0 ? (sub - 1) % 3 : 0;
      const int ni = sub < 12 ? sub / 3 : -1, ns = sub % 3;
      rn_phase(p, pi, ps, ni, ns, sub == 4, bid, nb, tidx);
    } else if (kind == K_PREP) prep_phase(p, bid, nb, smem, tidx);
    else if (kind == K_ATTN) attn_phase(p, arg, bid, nb, smem, tidx);
    else if (kind == K_S5A) s5_phase(p, 0, bid, nb, smem, tidx);
    else if (kind == K_S5B) s5_phase(p, 1, bid, nb, smem, tidx);
    else if (kind == K_S5C) s5c_phase(p, bid, nb, tidx);
    else if (kind == K_DNA) dna_phase(p, bid, nb, tidx);
    else if (kind == K_DNB) dnb_phase(p, bid, nb, smem, tidx);
    else if (kind == K_DNC) dnc_phase(p, bid, nb, smem, tidx);
    else dnd_phase(p, bid, nb, tidx);
    if (ph + 1 < phi) {
      if (pk.hi > 100000) grid.sync();
      xcd_barrier(xb);
    }
  }
}

extern "C" void kernel_launch(void* const* d_in, const int* in_sizes, int n_in, void* d_out, int out_size, void* d_ws, size_t ws_size,
                              hipStream_t stream) {
  static int grid_blocks = 0;
  if (!grid_blocks) {
    if (n_in != 38 || ws_size < WS_NEED) { fprintf(stderr, "kernel_launch: unexpected n_in %d or ws %zu < %zu\n", n_in, ws_size, (size_t)WS_NEED); grid_blocks = -1; return; }
    int dev = 0, cus = 0, per_cu = 0;
    hipGetDevice(&dev);
    hipDeviceGetAttribute(&cus, hipDeviceAttributeMultiprocessorCount, dev);
    hipFuncSetAttribute((const void*)mega, hipFuncAttributeMaxDynamicSharedMemorySize, SMEM);
    hipOccupancyMaxActiveBlocksPerMultiprocessor(&per_cu, mega, 256, SMEM);
    if (per_cu < 1) per_cu = 1;
    if (per_cu > 2) per_cu = 2;
    grid_blocks = cus * per_cu;
  }
  if (grid_blocks < 0) return;
  P p{};
  const float** pp = (const float**)&p;
  for (int i = 0; i < 38; ++i) pp[i] = (const float*)d_in[i];
  p.out = (float*)d_out;
  p.ws = (char*)d_ws;
  hipMemsetAsync((char*)d_ws + OFF_BAR, 0, 16384, stream);
#if MULTI_LAUNCH
  for (int ph = 0; ph < NPH; ++ph) {
    p.lo = ph; p.hi = ph + 1;
    hipLaunchKernelGGL(mega, dim3(grid_blocks), dim3(256), SMEM, stream, p);
  }
#else
  p.lo = 0; p.hi = NPH;
  void* args[] = {&p};
  hipError_t e = hipLaunchCooperativeKernel((void*)mega, dim3(grid_blocks), dim3(256), args, SMEM, stream);
  if (e != hipSuccess) fprintf(stderr, "cooperative launch failed: %s (grid %d)\n", hipGetErrorString(e), grid_blocks);
#endif
}
```
